# Optimizing an MI355X kernel written in HIP

```python
import math
import jax, jax.numpy as jnp
from jax import lax
import numpy as np

D_MODEL = 1024
BATCH = 4
SEQ = 4096
DEPTH = 4

N_MIXERS = 3
N_A = (DEPTH + 2) // 3
N_B = (DEPTH + 1) // 3
N_C = DEPTH // 3

PLE_DIM = 256
D_FF = 4 * D_MODEL
DEEP_ALPHA = (2.0 * DEPTH) ** 0.25
DEEP_BETA = (8.0 * DEPTH) ** -0.25
LN_EPS = 1e-5

REL_BUCKETS = 32
REL_MAX_DIST = 128

DA_HEADS = D_MODEL // 128
DA_HEAD_DIM = 64
DA_V_DIM = 2 * DA_HEAD_DIM
DA_EPS = 1e-5
Q_BLOCK = 128

GLA_HEADS = 4
GLA_DK = D_MODEL // 2 // GLA_HEADS
GLA_DV = D_MODEL // GLA_HEADS
GLA_GATE_RANK = 16
GLA_TAU = 16.0
GLA_CHUNK = 64
GLA_EPS = 1e-5

RW_HEAD = 64
RW_HEADS = D_MODEL // RW_HEAD
RW_DECAY_LORA = 64
RW_A_LORA = 64
RW_GATE_LORA = 128
RW_GN_EPS = 64e-5

kernel_name = 'hybrid_diffattn_gla_rwkv7_trunk'


def layer_norm(x, g, b, eps):
    xf = x.astype(jnp.float32)
    mu = jnp.mean(xf, -1, keepdims=True)
    var = jnp.mean(jnp.square(xf - mu), -1, keepdims=True)
    return ((xf - mu) * lax.rsqrt(var + eps)).astype(x.dtype) * g + b


def rms_norm(x, g, eps):
    xf = x.astype(jnp.float32)
    return (xf * lax.rsqrt(jnp.mean(xf * xf, -1, keepdims=True) + eps)).astype(x.dtype) * g


def t5_bucket(rel):
    n = jnp.maximum(rel, 0)
    max_exact = REL_BUCKETS // 2
    nf = jnp.maximum(n, 1).astype(jnp.float32)
    large = max_exact + (jnp.log(nf / max_exact) / math.log(REL_MAX_DIST / max_exact)
                         * (REL_BUCKETS - max_exact)).astype(jnp.int32)
    large = jnp.minimum(large, REL_BUCKETS - 1)
    return jnp.where(n < max_exact, n, large)


def diff_attention(x, w_qkv, w_o, lam_q1, lam_k1, lam_q2, lam_k2, subln_g, rel_bias, lam_init):
    B, S, _ = x.shape
    H, d = DA_HEADS, DA_HEAD_DIM
    q, k, v = jnp.split(x @ w_qkv, 3, axis=-1)
    q = q.reshape(B, S, H, 2, d) * (d ** -0.5)
    k = k.reshape(B, S, H, 2, d)
    v = v.reshape(B, S, H, DA_V_DIM)
    lam = (jnp.exp(jnp.sum(lam_q1 * lam_k1).astype(jnp.float32))
           - jnp.exp(jnp.sum(lam_q2 * lam_k2).astype(jnp.float32)) + lam_init)
    n_blocks = S // Q_BLOCK
    q_blocks = jnp.moveaxis(q.reshape(B, n_blocks, Q_BLOCK, H, 2, d), 1, 0)
    k_pos = jnp.arange(S)

    def attend_block(args):
        q_blk, blk = args
        q_pos = blk * Q_BLOCK + jnp.arange(Q_BLOCK)
        rel = q_pos[:, None] - k_pos[None, :]
        bias = jnp.moveaxis(rel_bias[t5_bucket(rel)], -1, 0).astype(jnp.float32)
        logits = jnp.einsum('bqhmd,bkhmd->bhmqk', q_blk, k).astype(jnp.float32) + bias[None, :, None]
        logits = jnp.where(rel >= 0, logits, -jnp.inf)
        probs = jax.nn.softmax(logits, axis=-1)
        attn = probs[:, :, 0] - lam * probs[:, :, 1]
        return jnp.einsum('bhqk,bkhe->bqhe', attn.astype(v.dtype), v)

    o = lax.map(attend_block, (q_blocks, jnp.arange(n_blocks)))
    o = jnp.moveaxis(o, 0, 1).reshape(B, S, H, DA_V_DIM)
    o = rms_norm(o, subln_g, DA_EPS) * (1.0 - lam_init)
    return o.reshape(B, S, H * DA_V_DIM) @ w_o


def gla(x, w_in, w_a1, w_a2, b_a, norm_g, w_o):
    B, S, _ = x.shape
    H, dk, dv, C = GLA_HEADS, GLA_DK, GLA_DV, GLA_CHUNK
    q, k, v, r = jnp.split(x @ w_in, [H * dk, 2 * H * dk, 2 * H * dk + H * dv], axis=-1)
    log_a = jax.nn.log_sigmoid((x @ w_a1) @ w_a2 + b_a) / GLA_TAU
    nC = S // C

    def to_chunks(t, e):
        return jnp.transpose(t.reshape(B, nC, C, H, e), (0, 3, 1, 2, 4)).astype(jnp.float32)

    q = to_chunks(q, dk) * (dk ** -0.5)
    k = to_chunks(k, dk)
    v = to_chunks(v, dv)
    b = jnp.cumsum(to_chunks(log_a, dk), axis=3)
    b_last = b[:, :, :, -1:]
    q_dec = q * jnp.exp(b)
    att = jnp.einsum('bhnid,bhnjd->bhnij', q_dec, k * jnp.exp(-b))
    att = jnp.where(jnp.tril(jnp.ones((C, C), bool)), att, 0.0)
    o_intra = jnp.einsum('bhnij,bhnje->bhnie', att, v)
    kv_chunk = jnp.einsum('bhnjd,bhnje->bhnde', k * jnp.exp(b_last - b), v)
    decay_chunk = jnp.exp(b_last[:, :, :, 0])

    def step(state, inp):
        kv_c, dec_c = inp
        return state * dec_c[..., None] + kv_c, state

    _, states_prev = lax.scan(step, jnp.zeros((B, H, dk, dv), jnp.float32),
                              (jnp.moveaxis(kv_chunk, 2, 0), jnp.moveaxis(decay_chunk, 2, 0)))
    states_prev = jnp.moveaxis(states_prev, 0, 2)
    o = o_intra + jnp.einsum('bhnid,bhnde->bhnie', q_dec, states_prev)
    o = jnp.transpose(o, (0, 2, 3, 1, 4)).reshape(B, S, H, dv)
    o = rms_norm(o, norm_g, GLA_EPS).astype(x.dtype) * jax.nn.silu(r).reshape(B, S, H, dv)
    return o.reshape(B, S, H * dv) @ w_o


def rwkv7_time_mix(x, mix, w_rkv, w0, w1, w2, a0, a1, a2, g1, g2, k_k, k_a, r_k, ln_g, ln_b, w_o):
    B, S, D = x.shape
    H, N = RW_HEADS, RW_HEAD
    xx = jnp.pad(x, ((0, 0), (1, 0), (0, 0)))[:, :-1] - x
    xm = x[:, :, None, :] + xx[:, :, None, :] * mix
    rkv = jnp.einsum('bsgd,gde->bsge', xm[:, :, :3], w_rkv)
    r, k, v = rkv[:, :, 0], rkv[:, :, 1], rkv[:, :, 2]
    xw, xa, xg = xm[:, :, 3], xm[:, :, 4], xm[:, :, 5]
    w_log = -jax.nn.softplus(-(w0 + jnp.tanh(xw @ w1) @ w2)) - 0.5
    decay = jnp.exp(-jnp.exp(w_log.astype(jnp.float32)))
    a = jax.nn.sigmoid(a0 + (xa @ a1) @ a2)
    g = jax.nn.sigmoid(xg @ g1) @ g2
    kk = (k * k_k).reshape(B, S, H, N).astype(jnp.float32)
    kk = kk * lax.rsqrt(jnp.maximum(jnp.sum(kk * kk, -1, keepdims=True), 1e-24))
    k = k * (1.0 + (a - 1.0) * k_a)

    def heads(t):
        return t.reshape(B, S, H, N).astype(jnp.float32)

    r_h, k_h, v_h, a_h, w_h = heads(r), heads(k), heads(v), heads(a), heads(decay)

    def step(state, inp):
        r_t, w_t, k_t, v_t, kk_t, a_t = inp
        sa = jnp.einsum('bhvk,bhk->bhv', state, -kk_t)
        state = (state * w_t[:, :, None, :] + sa[..., None] * (kk_t * a_t)[:, :, None, :]
                 + v_t[..., None] * k_t[:, :, None, :])
        return state, jnp.einsum('bhvk,bhk->bhv', state, r_t)

    seq_inputs = (jnp.moveaxis(r_h, 1, 0), jnp.moveaxis(w_h, 1, 0), jnp.moveaxis(k_h, 1, 0),
                  jnp.moveaxis(v_h, 1, 0), jnp.moveaxis(kk, 1, 0), jnp.moveaxis(a_h, 1, 0))
    _, y = lax.scan(step, jnp.zeros((B, H, N, N), jnp.float32), seq_inputs)
    y = jnp.moveaxis(y, 0, 1)
    y = layer_norm(y, ln_g.reshape(H, N), ln_b.reshape(H, N), RW_GN_EPS)
    y = y + jnp.sum(r_h * k_h * r_k, -1, keepdims=True) * v_h
    return (y.reshape(B, S, D).astype(x.dtype) * g) @ w_o


def sq_relu_mlp(x, w_up, w_down):
    return jnp.square(jax.nn.relu(x @ w_up)) @ w_down


def setup_inputs(seed: int = 0) -> dict:
    key = jax.random.key(seed)
    ks = iter(jax.random.split(key, 64))
    D = D_MODEL

    def nrm(shape, scale):
        return jax.random.normal(next(ks), shape, jnp.float32) * scale

    x = nrm((BATCH, SEQ, D), 1.0)
    p = nrm((DEPTH, BATCH, SEQ, PLE_DIM), 1.0)
    rel_bias = nrm((REL_BUCKETS, DA_HEADS), 0.5)
    ln1_g = 1.0 + nrm((DEPTH, D), 0.02)
    ln1_b = nrm((DEPTH, D), 0.02)
    ln2_g = 1.0 + nrm((DEPTH, D), 0.02)
    ln2_b = nrm((DEPTH, D), 0.02)
    mlp_up = nrm((DEPTH, D, D_FF), D ** -0.5)
    mlp_down = nrm((DEPTH, D_FF, D), D_FF ** -0.5 * DEEP_BETA)
    ple_proj = nrm((DEPTH, PLE_DIM, D), PLE_DIM ** -0.5)
    ple_gate = nrm((DEPTH, D, D), D ** -0.5)
    da_w_qkv = jnp.concatenate([nrm((N_A, D, 2 * D), D ** -0.5),
                                nrm((N_A, D, DA_HEADS * DA_V_DIM), D ** -0.5 * DEEP_BETA)], axis=-1)
    da_w_o = nrm((N_A, DA_HEADS * DA_V_DIM, D), D ** -0.5 * DEEP_BETA)
    da_lam_q1 = nrm((N_A, DA_HEAD_DIM), 0.1)
    da_lam_k1 = nrm((N_A, DA_HEAD_DIM), 0.1)
    da_lam_q2 = nrm((N_A, DA_HEAD_DIM), 0.1)
    da_lam_k2 = nrm((N_A, DA_HEAD_DIM), 0.1)
    da_subln_g = 1.0 + nrm((N_A, DA_V_DIM), 0.02)
    gla_w_in = jnp.concatenate([nrm((N_B, D, 2 * GLA_HEADS * GLA_DK), D ** -0.5),
                                nrm((N_B, D, GLA_HEADS * GLA_DV), D ** -0.5 * DEEP_BETA),
                                nrm((N_B, D, GLA_HEADS * GLA_DV), D ** -0.5)], axis=-1)
    gla_w_a1 = nrm((N_B, D, GLA_GATE_RANK), D ** -0.5)
    gla_w_a2 = nrm((N_B, GLA_GATE_RANK, GLA_HEADS * GLA_DK), GLA_GATE_RANK ** -0.5)
    gla_b_a = nrm((N_B, GLA_HEADS * GLA_DK), 0.1)
    gla_norm_g = 1.0 + nrm((N_B, GLA_DV), 0.02)
    gla_w_o = nrm((N_B, GLA_HEADS * GLA_DV, D), D ** -0.5 * DEEP_BETA)
    rw_mix = jax.random.uniform(next(ks), (N_C, 6, D), jnp.float32)
    rw_w_rkv = nrm((N_C, 3, D, D), D ** -0.5) * jnp.array([1.0, 1.0, DEEP_BETA], jnp.float32)[None, :, None, None]
    rw_w0 = -1.0 + nrm((N_C, D), 0.5)
    rw_w1 = nrm((N_C, D, RW_DECAY_LORA), D ** -0.5)
    rw_w2 = nrm((N_C, RW_DECAY_LORA, D), 0.1)
    rw_a0 = nrm((N_C, D), 0.1)
    rw_a1 = nrm((N_C, D, RW_A_LORA), D ** -0.5)
    rw_a2 = nrm((N_C, RW_A_LORA, D), 0.1)
    rw_g1 = nrm((N_C, D, RW_GATE_LORA), D ** -0.5)
    rw_g2 = nrm((N_C, RW_GATE_LORA, D), RW_GATE_LORA ** -0.5)
    rw_k_k = 0.85 + nrm((N_C, D), 0.02)
    rw_k_a = 1.0 + nrm((N_C, D), 0.02)
    rw_r_k = nrm((N_C, RW_HEADS, RW_HEAD), 0.1)
    rw_ln_g = 1.0 + nrm((N_C, D), 0.02)
    rw_ln_b = nrm((N_C, D), 0.02)
    rw_w_o = nrm((N_C, D, D), D ** -0.5 * DEEP_BETA)
    return {'x': x, 'p': p, 'rel_bias': rel_bias,
            'ln1_g': ln1_g, 'ln1_b': ln1_b, 'ln2_g': ln2_g, 'ln2_b': ln2_b,
            'mlp_up': mlp_up, 'mlp_down': mlp_down, 'ple_proj': ple_proj, 'ple_gate': ple_gate,
            'da_w_qkv': da_w_qkv, 'da_w_o': da_w_o, 'da_lam_q1': da_lam_q1, 'da_lam_k1': da_lam_k1,
            'da_lam_q2': da_lam_q2, 'da_lam_k2': da_lam_k2, 'da_subln_g': da_subln_g,
            'gla_w_in': gla_w_in, 'gla_w_a1': gla_w_a1, 'gla_w_a2': gla_w_a2, 'gla_b_a': gla_b_a,
            'gla_norm_g': gla_norm_g, 'gla_w_o': gla_w_o,
            'rw_mix': rw_mix, 'rw_w_rkv': rw_w_rkv, 'rw_w0': rw_w0, 'rw_w1': rw_w1, 'rw_w2': rw_w2,
            'rw_a0': rw_a0, 'rw_a1': rw_a1, 'rw_a2': rw_a2, 'rw_g1': rw_g1, 'rw_g2': rw_g2,
            'rw_k_k': rw_k_k, 'rw_k_a': rw_k_a, 'rw_r_k': rw_r_k, 'rw_ln_g': rw_ln_g, 'rw_ln_b': rw_ln_b,
            'rw_w_o': rw_w_o}


def reference(x, p, rel_bias, ln1_g, ln1_b, ln2_g, ln2_b, mlp_up, mlp_down, ple_proj, ple_gate,
              da_w_qkv, da_w_o, da_lam_q1, da_lam_k1, da_lam_q2, da_lam_k2, da_subln_g,
              gla_w_in, gla_w_a1, gla_w_a2, gla_b_a, gla_norm_g, gla_w_o,
              rw_mix, rw_w_rkv, rw_w0, rw_w1, rw_w2, rw_a0, rw_a1, rw_a2, rw_g1, rw_g2,
              rw_k_k, rw_k_a, rw_r_k, rw_ln_g, rw_ln_b, rw_w_o):
    h = x
    for i in range(DEPTH):
        kind, j = i % N_MIXERS, i // N_MIXERS
        if kind == 0:
            lam_init = 0.8 - 0.6 * math.exp(-0.3 * i)
            mixed = diff_attention(h, da_w_qkv[j], da_w_o[j], da_lam_q1[j], da_lam_k1[j],
                                   da_lam_q2[j], da_lam_k2[j], da_subln_g[j], rel_bias, lam_init)
        elif kind == 1:
            mixed = gla(h, gla_w_in[j], gla_w_a1[j], gla_w_a2[j], gla_b_a[j], gla_norm_g[j], gla_w_o[j])
        else:
            mixed = rwkv7_time_mix(h, rw_mix[j], rw_w_rkv[j], rw_w0[j], rw_w1[j], rw_w2[j],
                                   rw_a0[j], rw_a1[j], rw_a2[j], rw_g1[j], rw_g2[j],
                                   rw_k_k[j], rw_k_a[j], rw_r_k[j], rw_ln_g[j], rw_ln_b[j], rw_w_o[j])
        h = layer_norm(DEEP_ALPHA * h + mixed, ln1_g[i], ln1_b[i], LN_EPS)
        h = layer_norm(DEEP_ALPHA * h + sq_relu_mlp(h, mlp_up[i], mlp_down[i]), ln2_g[i], ln2_b[i], LN_EPS)
        h = h + jax.nn.sigmoid(h @ ple_gate[i]) * (p[i] @ ple_proj[i])
    return h
```

```cpp
#include <hip/hip_runtime.h>
#include <cstdio>
#include <cmath>
namespace orc {
constexpr int D = 1024, BATCH = 4, SEQ = 4096, DEPTH = 4, M = BATCH * SEQ, R = SEQ;
constexpr float ALPHA = 1.681792830507429f;
__device__ const unsigned char BUCKET[128] = {0,1,2,3,4,5,6,7,8,9,10,11,12,13,14,15,16,16,16,17,17,18,18,18,19,19,19,20,20,20,20,21,21,21,21,22,22,22,22,22,23,23,23,23,23,23,24,24,24,24,24,24,25,25,25,25,25,25,25,26,26,26,26,26,26,26,26,27,27,27,27,27,27,27,27,27,27,28,28,28,28,28,28,28,28,28,28,29,29,29,29,29,29,29,29,29,29,29,29,30,30,30,30,30,30,30,30,30,30,30,30,30,30,31,31,31,31,31,31,31,31,31,31,31,31,31,31,31};

__global__ void __launch_bounds__(256) ogemm(const float* __restrict__ A, int lda, const float* __restrict__ B, int ldb, float* __restrict__ C, int ldc, int Mr, int N, int K) {
    __shared__ float As[16][68];
    __shared__ float Bs[16][68];
    const int tx = threadIdx.x & 15, ty = threadIdx.x >> 4;
    const int m0 = blockIdx.y * 64, n0 = blockIdx.x * 64;
    float acc[4][4];
#pragma unroll
    for (int i = 0; i < 4; ++i)
#pragma unroll
        for (int j = 0; j < 4; ++j) acc[i][j] = 0.f;
    for (int k0 = 0; k0 < K; k0 += 16) {
#pragma unroll
        for (int i = 0; i < 4; ++i) {
            const int e = threadIdx.x + i * 256;
            const int r = e >> 4, c = e & 15;
            As[c][r] = A[(size_t)(m0 + r) * lda + k0 + c];
            const int rb = e >> 6, cb = e & 63;
            Bs[rb][cb] = (n0 + cb < N) ? B[(size_t)(k0 + rb) * ldb + n0 + cb] : 0.f;
        }
        __syncthreads();
#pragma unroll
        for (int kk = 0; kk < 16; ++kk) {
            float a[4], b[4];
#pragma unroll
            for (int i = 0; i < 4; ++i) { a[i] = As[kk][ty * 4 + i]; b[i] = Bs[kk][tx * 4 + i]; }
#pragma unroll
            for (int i = 0; i < 4; ++i)
#pragma unroll
                for (int j = 0; j < 4; ++j) acc[i][j] = fmaf(a[i], b[j], acc[i][j]);
        }
        __syncthreads();
    }
#pragma unroll
    for (int i = 0; i < 4; ++i)
#pragma unroll
        for (int j = 0; j < 4; ++j) { const int n = n0 + tx * 4 + j; if (n < N) C[(size_t)(m0 + ty * 4 + i) * ldc + n] = acc[i][j]; }
}
static void gemm(hipStream_t s, const float* A, int lda, const float* B, int ldb, float* C, int ldc, int Mr, int N, int K) {
    hipLaunchKernelGGL(ogemm, dim3((N + 63) / 64, Mr / 64), dim3(256), 0, s, A, lda, B, ldb, C, ldc, Mr, N, K);
}

__device__ __forceinline__ float wsum(float v) {
#pragma unroll
    for (int o = 1; o < 64; o <<= 1) v += __shfl_xor(v, o);
    return v;
}
__global__ void __launch_bounds__(256) oln(const float* h, const float* add, const float* g, const float* b, float* out, int rows, float eps) {
    const int row = blockIdx.x * 4 + (threadIdx.x >> 6), lane = threadIdx.x & 63;
    if (row >= rows) return;
    float v[16]; float s = 0.f;
#pragma unroll
    for (int j = 0; j < 16; ++j) { const int c = lane + 64 * j; v[j] = ALPHA * h[(size_t)row * D + c] + add[(size_t)row * D + c]; s += v[j]; }
    const float mu = wsum(s) * (1.f / D); float q = 0.f;
#pragma unroll
    for (int j = 0; j < 16; ++j) { v[j] -= mu; q += v[j] * v[j]; }
    const float rs = 1.0f / sqrtf(wsum(q) * (1.f / D) + eps);
#pragma unroll
    for (int j = 0; j < 16; ++j) { const int c = lane + 64 * j; out[(size_t)row * D + c] = v[j] * rs * g[c] + b[c]; }
}
__global__ void osqrelu(float* t, size_t n) { size_t i = (size_t)blockIdx.x * 256 + threadIdx.x; if (i < n) { float v = t[i]; v = v > 0.f ? v : 0.f; t[i] = v * v; } }
__device__ __forceinline__ float sigm(float x) { return 1.f / (1.f + expf(-x)); }
__global__ void ople(float* h, const float* gate, const float* proj, size_t n) { size_t i = (size_t)blockIdx.x * 256 + threadIdx.x; if (i < n) h[i] = h[i] + sigm(gate[i]) * proj[i]; }
__global__ void ocopy(float* d, const float* s, size_t n) { size_t i = (size_t)blockIdx.x * 256 + threadIdx.x; if (i < n) d[i] = s[i]; }

__global__ void __launch_bounds__(128) oattn(const float* __restrict__ QKV, const float* __restrict__ rel_bias, const float* lq1, const float* lk1, const float* lq2, const float* lk2,
                                             const float* __restrict__ subg, float lam_init, float* __restrict__ O) {
    __shared__ float sc[2][SEQ];
    __shared__ float qv[128];
    __shared__ float red[8];
    const int q = blockIdx.x, h = blockIdx.y, tid = threadIdx.x;
    float l1 = 0.f, l2 = 0.f;
    for (int i = 0; i < 64; ++i) { l1 += lq1[i] * lk1[i]; l2 += lq2[i] * lk2[i]; }
    const float lam = expf(l1) - expf(l2) + lam_init;
    qv[tid] = QKV[(size_t)q * 3072 + h * 128 + tid] * 0.125f;
    __syncthreads();
    float mx0 = -INFINITY, mx1 = -INFINITY;
    for (int k = tid; k <= q; k += 128) {
        const float* kr = QKV + (size_t)k * 3072 + 1024 + h * 128;
        float s0 = 0.f, s1 = 0.f;
        for (int d = 0; d < 64; ++d) { s0 = fmaf(qv[d], kr[d], s0); s1 = fmaf(qv[64 + d], kr[64 + d], s1); }
        const int n = q - k; const int bk = n < 128 ? BUCKET[n] : 31;
        const float bias = rel_bias[bk * 8 + h];
        s0 += bias; s1 += bias;
        sc[0][k] = s0; sc[1][k] = s1; mx0 = fmaxf(mx0, s0); mx1 = fmaxf(mx1, s1);
    }
    for (int o = 1; o < 64; o <<= 1) { mx0 = fmaxf(mx0, __shfl_xor(mx0, o)); mx1 = fmaxf(mx1, __shfl_xor(mx1, o)); }
    if ((tid & 63) == 0) { red[(tid >> 6) * 2] = mx0; red[(tid >> 6) * 2 + 1] = mx1; }
    __syncthreads();
    mx0 = fmaxf(red[0], red[2]); mx1 = fmaxf(red[1], red[3]);
    float su0 = 0.f, su1 = 0.f;
    for (int k = tid; k <= q; k += 128) { const float e0 = expf(sc[0][k] - mx0), e1 = expf(sc[1][k] - mx1); sc[0][k] = e0; sc[1][k] = e1; su0 += e0; su1 += e1; }
    su0 = wsum(su0); su1 = wsum(su1);
    __syncthreads();
    if ((tid & 63) == 0) { red[4 + (tid >> 6) * 2] = su0; red[4 + (tid >> 6) * 2 + 1] = su1; }
    __syncthreads();
    const float i0 = 1.f / (red[4] + red[6]), i1 = lam / (red[5] + red[7]);
    float o = 0.f;
    const float* vb = QKV + 2048 + h * 128 + tid;
    for (int k = 0; k <= q; ++k) o = fmaf(sc[0][k] * i0 - sc[1][k] * i1, vb[(size_t)k * 3072], o);
    float ss = wsum(o * o);
    __syncthreads();
    if ((tid & 63) == 0) red[tid >> 6] = ss;
    __syncthreads();
    const float rms = 1.0f / sqrtf((red[0] + red[1]) * (1.f / 128.f) + 1e-5f);
    O[(size_t)q * D + h * 128 + tid] = o * rms * subg[tid] * (1.f - lam_init);
}

__global__ void ogla_la(float* LA, const float* b_a, size_t n) { size_t i = (size_t)blockIdx.x * 256 + threadIdx.x; if (i < n) { float x = LA[i] + b_a[i & 511]; float ls = fminf(x, 0.f) - log1pf(expf(-fabsf(x))); LA[i] = ls * (1.f / 16.f); } }
__global__ void __launch_bounds__(256) ogla_scan(const float* __restrict__ XW, const float* __restrict__ LA, float* __restrict__ Oo) {
    __shared__ float sq[128], sk[128], sd[128];
    const int h = blockIdx.x, e = threadIdx.x;
    float st[128];
#pragma unroll
    for (int d = 0; d < 128; ++d) st[d] = 0.f;
    const float scale = 0.08838834764831845f;
    for (int t = 0; t < R; ++t) {
        __syncthreads();
        if (e < 128) { sq[e] = XW[(size_t)t * 3072 + h * 128 + e] * scale; sk[e] = XW[(size_t)t * 3072 + 512 + h * 128 + e]; sd[e] = expf(LA[(size_t)t * 512 + h * 128 + e]); }
        __syncthreads();
        const float v = XW[(size_t)t * 3072 + 1024 + h * 256 + e];
        float o = 0.f;
#pragma unroll
        for (int d = 0; d < 128; ++d) { st[d] = fmaf(st[d], sd[d], sk[d] * v); o = fmaf(sq[d], st[d], o); }
        Oo[(size_t)t * D + h * 256 + e] = o;
    }
}
__global__ void __launch_bounds__(256) ogla_out(const float* __restrict__ Oo, const float* __restrict__ XW, const float* __restrict__ ng, float* __restrict__ Y) {
    __shared__ float red[4];
    const int t = blockIdx.x, h = blockIdx.y, e = threadIdx.x;
    const float o = Oo[(size_t)t * D + h * 256 + e];
    float ss = wsum(o * o);
    if ((e & 63) == 0) red[e >> 6] = ss;
    __syncthreads();
    const float rms = 1.0f / sqrtf((red[0] + red[1] + red[2] + red[3]) * (1.f / 256.f) + 1e-5f);
    const float r = XW[(size_t)t * 3072 + 2048 + h * 256 + e];
    Y[(size_t)t * D + h * 256 + e] = o * rms * ng[e] * (r * sigm(r));
}

__global__ void orw_mix(const float* __restrict__ x, const float* __restrict__ mix, float* __restrict__ xm) {
    const size_t i = (size_t)blockIdx.x * 256 + threadIdx.x; const int t = (int)(i >> 10), c = (int)(i & 1023);
    const float xv = x[i], xp = t > 0 ? x[i - 1024] : 0.f;
    xm[i] = xv + (xp - xv) * mix[c];
}
__global__ void orw_act(float* t, size_t n, int kind) { size_t i = (size_t)blockIdx.x * 256 + threadIdx.x; if (i < n) { float v = t[i]; t[i] = kind == 0 ? tanhf(v) : sigm(v); } }
__global__ void orw_decay(float* w, const float* w0, size_t n) { size_t i = (size_t)blockIdx.x * 256 + threadIdx.x; if (i < n) { float z = -(w0[i & 1023] + w[i]); float sp = fmaxf(z, 0.f) + log1pf(expf(-fabsf(z))); float wl = -sp - 0.5f; w[i] = expf(-expf(wl)); } }
__global__ void orw_a(float* a, const float* a0, size_t n) { size_t i = (size_t)blockIdx.x * 256 + threadIdx.x; if (i < n) a[i] = sigm(a0[i & 1023] + a[i]); }
__global__ void __launch_bounds__(64) orw_kk(float* __restrict__ K, const float* __restrict__ A, const float* __restrict__ k_k, const float* __restrict__ k_a, float* __restrict__ KK) {
    const int t = blockIdx.x, h = blockIdx.y, j = threadIdx.x; const size_t i = (size_t)t * D + h * 64 + j; const int c = h * 64 + j;
    const float k = K[i]; const float kk = k * k_k[c];
    const float ss = wsum(kk * kk);
    KK[i] = kk * (1.0f / sqrtf(fmaxf(ss, 1e-24f)));
    K[i] = k * (1.f + (A[i] - 1.f) * k_a[c]);
}
__global__ void __launch_bounds__(64) orw_scan(const float* __restrict__ Rr, const float* __restrict__ W, const float* __restrict__ K, const float* __restrict__ V, const float* __restrict__ KK, const float* __restrict__ A, float* __restrict__ Y) {
    __shared__ float sr[64], sw[64], sk[64], skk[64], sb[64];
    const int h = blockIdx.x, v = threadIdx.x;
    float st[64];
#pragma unroll
    for (int j = 0; j < 64; ++j) st[j] = 0.f;
    for (int t = 0; t < R; ++t) {
        const size_t i = (size_t)t * D + h * 64 + v;
        __syncthreads();
        sr[v] = Rr[i]; sw[v] = W[i]; sk[v] = K[i]; const float kkv = KK[i]; skk[v] = kkv; sb[v] = kkv * A[i];
        __syncthreads();
        const float vv = V[i];
        float sa = 0.f;
#pragma unroll
        for (int j = 0; j < 64; ++j) sa = fmaf(st[j], -skk[j], sa);
        float y = 0.f;
#pragma unroll
        for (int j = 0; j < 64; ++j) { st[j] = st[j] * sw[j] + sa * sb[j] + vv * sk[j]; y = fmaf(st[j], sr[j], y); }
        Y[i] = y;
    }
}
__global__ void __launch_bounds__(64) orw_out(const float* __restrict__ Y, const float* __restrict__ Rr, const float* __restrict__ K, const float* __restrict__ V, const float* __restrict__ G,
                                              const float* __restrict__ r_k, const float* __restrict__ lg, const float* __restrict__ lb, float* __restrict__ O) {
    const int t = blockIdx.x, h = blockIdx.y, j = threadIdx.x; const size_t i = (size_t)t * D + h * 64 + j; const int c = h * 64 + j;
    const float y = Y[i];
    const float mu = wsum(y) * (1.f / 64.f); const float d = y - mu; const float var = wsum(d * d) * (1.f / 64.f);
    float o = d * (1.0f / sqrtf(var + 64e-5f)) * lg[c] + lb[c];
    const float bonus = wsum(Rr[i] * K[i] * r_k[c]);
    o += bonus * V[i];
    O[i] = o * G[i];
}

static inline dim3 g1(size_t n) { return dim3((unsigned)((n + 255) / 256)); }

static void forward(void* const* d_in, float* Hs, float* ws, hipStream_t s) {
    const float* x = (const float*)d_in[0]; const float* p = (const float*)d_in[1]; const float* rel_bias = (const float*)d_in[2];
    const float* ln1_g = (const float*)d_in[3]; const float* ln1_b = (const float*)d_in[4]; const float* ln2_g = (const float*)d_in[5]; const float* ln2_b = (const float*)d_in[6];
    const float* mlp_up = (const float*)d_in[7]; const float* mlp_down = (const float*)d_in[8]; const float* ple_proj = (const float*)d_in[9]; const float* ple_gate = (const float*)d_in[10];
    const size_t RD = (size_t)R * D;
    float* T0 = ws;
    float* X[12]; for (int i = 0; i < 12; ++i) X[i] = ws + (size_t)R * 4096 + (size_t)i * RD;
    hipLaunchKernelGGL(ocopy, g1((size_t)M * D), dim3(256), 0, s, Hs, x, (size_t)M * D);
    for (int i = 0; i < DEPTH; ++i) {
        const int kind = i % 3, j = i / 3;
        for (int b = 0; b < BATCH; ++b) {
            float* hb = Hs + (size_t)b * RD;
            if (kind == 0) {
                const float lam_init = 0.8f - 0.6f * expf(-0.3f * (float)i);
                const float* wqkv = (const float*)d_in[11] + (size_t)j * D * 3072; const float* wo = (const float*)d_in[12] + (size_t)j * D * D;
                gemm(s, hb, D, wqkv, 3072, T0, 3072, R, 3072, D);
                hipLaunchKernelGGL(oattn, dim3(R, 8), dim3(128), 0, s, T0, rel_bias, (const float*)d_in[13] + j * 64, (const float*)d_in[14] + j * 64, (const float*)d_in[15] + j * 64, (const float*)d_in[16] + j * 64,
                                   (const float*)d_in[17] + j * 128, lam_init, X[1]);
                gemm(s, X[1], D, wo, D, X[0], D, R, D, D);
            } else if (kind == 1) {
                const float* w_in = (const float*)d_in[18] + (size_t)j * D * 3072; const float* w_a1 = (const float*)d_in[19] + (size_t)j * D * 16; const float* w_a2 = (const float*)d_in[20] + (size_t)j * 16 * 512;
                const float* b_a = (const float*)d_in[21] + j * 512; const float* ng = (const float*)d_in[22] + j * 256; const float* wo = (const float*)d_in[23] + (size_t)j * D * D;
                gemm(s, hb, D, w_in, 3072, T0, 3072, R, 3072, D);
                gemm(s, hb, D, w_a1, 16, X[2], 16, R, 16, D);
                gemm(s, X[2], 16, w_a2, 512, X[3], 512, R, 512, 16);
                hipLaunchKernelGGL(ogla_la, g1((size_t)R * 512), dim3(256), 0, s, X[3], b_a, (size_t)R * 512);
                hipLaunchKernelGGL(ogla_scan, dim3(4), dim3(256), 0, s, T0, X[3], X[4]);
                hipLaunchKernelGGL(ogla_out, dim3(R, 4), dim3(256), 0, s, X[4], T0, ng, X[1]);
                gemm(s, X[1], D, wo, D, X[0], D, R, D, D);
            } else {
                const float* mix = (const float*)d_in[24] + (size_t)j * 6 * D; const float* w_rkv = (const float*)d_in[25] + (size_t)j * 3 * D * D;
                const float* w0 = (const float*)d_in[26] + j * D; const float* w1 = (const float*)d_in[27] + (size_t)j * D * 64; const float* w2 = (const float*)d_in[28] + (size_t)j * 64 * D;
                const float* a0 = (const float*)d_in[29] + j * D; const float* a1 = (const float*)d_in[30] + (size_t)j * D * 64; const float* a2 = (const float*)d_in[31] + (size_t)j * 64 * D;
                const float* g1w = (const float*)d_in[32] + (size_t)j * D * 128; const float* g2w = (const float*)d_in[33] + (size_t)j * 128 * D;
                const float* k_k = (const float*)d_in[34] + j * D; const float* k_a = (const float*)d_in[35] + j * D; const float* r_k = (const float*)d_in[36] + j * D;
                const float* lg = (const float*)d_in[37] + j * D; const float* lb = (const float*)d_in[38] + j * D; const float* wo = (const float*)d_in[39] + (size_t)j * D * D;
                float *XM = X[1], *Rr = X[2], *Kk = X[3], *Vv = X[4], *Ww = X[5], *Aa = X[6], *Gg = X[7], *KK = X[8], *Yy = X[9], *L = X[10];
                float* outs[3] = {Rr, Kk, Vv};
                for (int g = 0; g < 3; ++g) { hipLaunchKernelGGL(orw_mix, g1(RD), dim3(256), 0, s, hb, mix + g * D, XM); gemm(s, XM, D, w_rkv + (size_t)g * D * D, D, outs[g], D, R, D, D); }
                hipLaunchKernelGGL(orw_mix, g1(RD), dim3(256), 0, s, hb, mix + 3 * D, XM); gemm(s, XM, D, w1, 64, L, 64, R, 64, D);
                hipLaunchKernelGGL(orw_act, g1((size_t)R * 64), dim3(256), 0, s, L, (size_t)R * 64, 0); gemm(s, L, 64, w2, D, Ww, D, R, D, 64);
                hipLaunchKernelGGL(orw_decay, g1(RD), dim3(256), 0, s, Ww, w0, RD);
                hipLaunchKernelGGL(orw_mix, g1(RD), dim3(256), 0, s, hb, mix + 4 * D, XM); gemm(s, XM, D, a1, 64, L, 64, R, 64, D);
                gemm(s, L, 64, a2, D, Aa, D, R, D, 64);
                hipLaunchKernelGGL(orw_a, g1(RD), dim3(256), 0, s, Aa, a0, RD);
                hipLaunchKernelGGL(orw_mix, g1(RD), dim3(256), 0, s, hb, mix + 5 * D, XM); gemm(s, XM, D, g1w, 128, L, 128, R, 128, D);
                hipLaunchKernelGGL(orw_act, g1((size_t)R * 128), dim3(256), 0, s, L, (size_t)R * 128, 1); gemm(s, L, 128, g2w, D, Gg, D, R, D, 128);
                hipLaunchKernelGGL(orw_kk, dim3(R, 16), dim3(64), 0, s, Kk, Aa, k_k, k_a, KK);
                hipLaunchKernelGGL(orw_scan, dim3(16), dim3(64), 0, s, Rr, Ww, Kk, Vv, KK, Aa, Yy);
                hipLaunchKernelGGL(orw_out, dim3(R, 16), dim3(64), 0, s, Yy, Rr, Kk, Vv, Gg, r_k, lg, lb, XM);
                gemm(s, XM, D, wo, D, X[0], D, R, D, D);
            }
            hipLaunchKernelGGL(oln, dim3(R / 4), dim3(256), 0, s, hb, X[0], ln1_g + i * D, ln1_b + i * D, hb, R, 1e-5f);
            gemm(s, hb, D, mlp_up + (size_t)i * D * 4096, 4096, T0, 4096, R, 4096, D);
            hipLaunchKernelGGL(osqrelu, g1((size_t)R * 4096), dim3(256), 0, s, T0, (size_t)R * 4096);
            gemm(s, T0, 4096, mlp_down + (size_t)i * 4096 * D, D, X[0], D, R, D, 4096);
            hipLaunchKernelGGL(oln, dim3(R / 4), dim3(256), 0, s, hb, X[0], ln2_g + i * D, ln2_b + i * D, hb, R, 1e-5f);
            gemm(s, hb, D, ple_gate + (size_t)i * D * D, D, X[0], D, R, D, D);
            gemm(s, p + ((size_t)i * BATCH + b) * R * 256, 256, ple_proj + (size_t)i * 256 * D, D, X[1], D, R, D, 256);
            hipLaunchKernelGGL(ople, g1(RD), dim3(256), 0, s, hb, X[0], X[1], RD);
        }
    }
}
}
extern "C" void kernel_launch(void* const* d_in, const int* in_sizes, int n_in, void* d_out, int out_size, void* d_ws, size_t ws_size, hipStream_t stream) {
    orc::forward(d_in, (float*)d_out, (float*)d_ws, stream);
}
```

```cpp
#include <hip/hip_runtime.h>
#include <cstdio>
#include <cmath>
#include <cstdint>
#include <cstddef>
namespace pg8 {
#define PG8_LAS __attribute__((address_space(3)))
typedef unsigned short bf16_t;
typedef short bf16x8 __attribute__((ext_vector_type(8)));
typedef float f32x4 __attribute__((ext_vector_type(4)));
typedef unsigned u32x4 __attribute__((ext_vector_type(4)));
constexpr int BM = 256, BK = 64, HALF = 128, HTB = HALF * BK * 2  , STAGE_BYTES = 8 * HTB, NXCD = 8, WGM = 8;

__host__ __device__ __forceinline__ int lds_byte(int r, int c) { const int st = (r >> 4) * 2 + (c >> 5), rr = r & 15, cc = c & 31, ob = rr * 64 + cc * 2; return st * 1024 + (ob ^ (((ob >> 9) & 1) << 5)); }
__host__ __device__ __forceinline__ void stage_rc(int b, int& R, int& C) { const int st = b / 1024, sb = b % 1024, swz = sb ^ (((sb >> 9) & 1) << 5); R = (st >> 1) * 16 + swz / 64; C = (st & 1) * 32 + (swz % 64) / 2; }
__host__ __device__ __forceinline__ int perm32(int rho) { const int n = rho >> 4, i = rho & 15; return 8 * (i >> 2) + 4 * n + (i & 3); }

struct Unit { int pm, pn, gi, nt; const char* A; const char* B; };

__device__ __forceinline__ unsigned cvt_pk_bf16(float lo, float hi) { unsigned r; asm volatile("v_cvt_pk_bf16_f32 %0, %1, %2" : "=v"(r) : "v"(lo), "v"(hi)); return r; }
typedef float f32x2 __attribute__((ext_vector_type(2)));
__device__ __forceinline__ f32x2 gelu_pk(f32x2 v) {
    const f32x2 av = __builtin_elementwise_abs(v), d = av * 0.2316418882f + 1.0f;
    f32x2 t; t.x = __builtin_amdgcn_rcpf(d.x); t.y = __builtin_amdgcn_rcpf(d.y);
    f32x2 q = t * 0.5307027145f + (-0.7265760135f); q = q * t + 0.7107068705f; q = q * t + (-0.142248368f); q = q * t + 0.127414796f; q = q * t;
    const f32x2 s = (v * v) * (-0.72134752044f);
    f32x2 e; e.x = __builtin_amdgcn_exp2f(s.x); e.y = __builtin_amdgcn_exp2f(s.y);
    const f32x2 m = v * (q * e), r = v - m;
    f32x2 o; o.x = v.x < 0.f ? m.x : r.x; o.y = v.y < 0.f ? m.y : r.y; return o;
}

template <int ACT  > struct EpiBf16 {
    static constexpr bool PERM = true, AFTER_DRAIN = false; static_assert(ACT == 0 || ACT == 1, "EpiBf16: ACT is 0 (none) or 1 (gelu_pk)");
    bf16_t* O; int ldc; const float* bias; int split_cols; size_t split_stride; float scale0;
    __device__ __forceinline__ void operator()(const f32x4 (&acc)[2][2][4][2], const Unit& u, int wr, int wc, int fr, int fq) const {
        const int row0 = u.pm * BM + wr * 64 + fr; int colt = u.pn * BM; bf16_t* base = O;
        float sc = 1.f; if (split_cols) { const int t = colt / split_cols; base += (size_t)t * split_stride; colt -= t * split_cols; if (t == 0) sc = scale0; }
        const int col0 = colt + wc * 32 + 8 * fq, bcol0 = u.pn * BM + wc * 32 + 8 * fq;
        f32x4 bv[2][2];
#pragma unroll
        for (int bj = 0; bj < 2; ++bj)
#pragma unroll
            for (int n = 0; n < 2; ++n) bv[bj][n] = bias ? *(const f32x4*)(bias + bcol0 + bj * HALF + 4 * n) : (f32x4){0.f, 0.f, 0.f, 0.f};
#pragma unroll
        for (int ai = 0; ai < 2; ++ai)
#pragma unroll
            for (int m = 0; m < 4; ++m) { bf16_t* rowp = base + (size_t)(row0 + ai * HALF + m * 16) * ldc + col0;
#pragma unroll
                for (int bj = 0; bj < 2; ++bj) { f32x4 v0 = acc[ai][bj][m][0] + bv[bj][0], v1 = acc[ai][bj][m][1] + bv[bj][1];
                    if (ACT == 1) { f32x2 a = gelu_pk((f32x2){v0[0], v0[1]}), b = gelu_pk((f32x2){v0[2], v0[3]}), c = gelu_pk((f32x2){v1[0], v1[1]}), d = gelu_pk((f32x2){v1[2], v1[3]});
                        v0 = (f32x4){a.x, a.y, b.x, b.y}; v1 = (f32x4){c.x, c.y, d.x, d.y}; }
                    v0 = v0 * sc; v1 = v1 * sc; u32x4 w; w.x = cvt_pk_bf16(v0[0], v0[1]); w.y = cvt_pk_bf16(v0[2], v0[3]); w.z = cvt_pk_bf16(v1[0], v1[1]); w.w = cvt_pk_bf16(v1[2], v1[3]);
                    *(u32x4*)(rowp + bj * HALF) = w; } }
    }
};

struct PanelStats {
    unsigned* xbuf;
    unsigned* cnt;
    unsigned* tmo;
    int ntn; float eps;
    unsigned code;
    __device__ __forceinline__ bool run(const f32x4 (&v)[2][2][4][2], const Unit& u, int wr, int wc, int fr, int fq, PG8_LAS unsigned char* lds, int wid, int lane) const {
        typedef float f32x2v __attribute__((ext_vector_type(2)));
        PG8_LAS f32x2v* P = (PG8_LAS f32x2v*)lds;
        PG8_LAS f32x2v* S = (PG8_LAS f32x2v*)(lds + 8192);
        PG8_LAS unsigned* flag = (PG8_LAS unsigned*)(lds + 8192 + 2048);
#pragma unroll
        for (int ai = 0; ai < 2; ++ai)
#pragma unroll
            for (int m = 0; m < 4; ++m) {
                float s = 0.f;
#pragma unroll
                for (int bj = 0; bj < 2; ++bj)
#pragma unroll
                    for (int n = 0; n < 2; ++n) { const f32x4 x = v[ai][bj][m][n]; s += (x[0] + x[1]) + (x[2] + x[3]); }
                s += __shfl_xor(s, 16); s += __shfl_xor(s, 32);
                const float mw = s * (1.0f / 64.0f); float q = 0.f;
#pragma unroll
                for (int bj = 0; bj < 2; ++bj)
#pragma unroll
                    for (int n = 0; n < 2; ++n) { const f32x4 d = v[ai][bj][m][n] - mw; q += (d[0] * d[0] + d[1] * d[1]) + (d[2] * d[2] + d[3] * d[3]); }
                q += __shfl_xor(q, 16); q += __shfl_xor(q, 32);
                if (fq == 0) P[(ai * HALF + wr * 64 + m * 16 + fr) * 4 + wc] = (f32x2v){mw, q};
            }
        asm volatile("s_waitcnt lgkmcnt(0)" ::: "memory"); __builtin_amdgcn_s_barrier(); asm volatile("" ::: "memory");
#if defined(BROKEN_EXCHANGE_NO_WAIT)
#warning BROKEN CONTROL BUILD: the row-statistics exchange does not wait; results are wrong by design
        if (blockIdx.x >= 64) { const long long t0_ = clock64(); while (clock64() - t0_ < 60000) __builtin_amdgcn_s_sleep(8); }
#endif
        const int row = wid * 32 + (lane & 31);
        if (lane < 32) {
            const f32x2v a = P[row * 4 + 0], b = P[row * 4 + 1], c = P[row * 4 + 2], d = P[row * 4 + 3];
            const float mt = (a.x + b.x + c.x + d.x) * 0.25f;
            const float da = a.x - mt, db = b.x - mt, dc = c.x - mt, dd = d.x - mt;
            const float m2 = (a.y + b.y) + (c.y + d.y) + 64.0f * ((da * da + db * db) + (dc * dc + dd * dd));
            unsigned long long* slot = (unsigned long long*)xbuf + ((size_t)(u.pm * BM + row) * 4 + u.pn);
            __hip_atomic_store(slot, ((unsigned long long)__float_as_uint(m2) << 32) | __float_as_uint(mt), __ATOMIC_RELAXED, __HIP_MEMORY_SCOPE_AGENT);
        }
        asm volatile("s_waitcnt vmcnt(0)" ::: "memory");
        if (lane == 0) __hip_atomic_fetch_add(cnt + 64 * u.pm, 1u, __ATOMIC_RELAXED, __HIP_MEMORY_SCOPE_AGENT);
        if (wid == 0) {
            bool dead = false; const unsigned long long t0 = __builtin_amdgcn_s_memrealtime(); const unsigned want = 8u * (unsigned)ntn;
            for (;;) {
#if defined(BROKEN_EXCHANGE_NO_WAIT)
                break;
#endif
                if ((unsigned)__builtin_amdgcn_readfirstlane(__hip_atomic_load(cnt + 64 * u.pm, __ATOMIC_RELAXED, __HIP_MEMORY_SCOPE_AGENT)) >= want) break;
                if (__builtin_amdgcn_s_memrealtime() - t0 > 2000000ull) {
                    if (lane == 0) { unsigned expect = 0u; __hip_atomic_compare_exchange_strong(tmo + 1, &expect, code | (unsigned)(u.pm & 0xff), __ATOMIC_RELAXED, __ATOMIC_RELAXED, __HIP_MEMORY_SCOPE_AGENT);
                                     __hip_atomic_store(tmo, 1u, __ATOMIC_RELAXED, __HIP_MEMORY_SCOPE_AGENT); }
                    dead = true; break; }
                __builtin_amdgcn_s_sleep(2);
            }
            __builtin_amdgcn_fence(__ATOMIC_ACQUIRE, "agent");
            if (lane == 0) flag[0] = dead ? 1u : 0u;
        }
        asm volatile("s_waitcnt vmcnt(0) lgkmcnt(0)" ::: "memory"); __builtin_amdgcn_s_barrier(); asm volatile("" ::: "memory");
        const bool bad = flag[0] != 0u;
        if (lane < 32) {
            const unsigned long long* slot = (const unsigned long long*)xbuf + (size_t)(u.pm * BM + row) * 4; float mt[4], m2[4]; float ms = 0.f;
#pragma unroll
            for (int t = 0; t < 4; ++t) { if (t < ntn) { const unsigned long long w = __hip_atomic_load(slot + t, __ATOMIC_RELAXED, __HIP_MEMORY_SCOPE_AGENT); mt[t] = __uint_as_float((unsigned)w); m2[t] = __uint_as_float((unsigned)(w >> 32)); } else { mt[t] = 0.f; m2[t] = 0.f; } ms += mt[t]; }
            const float mean = ms / (float)ntn; float q = 0.f;
#pragma unroll
            for (int t = 0; t < 4; ++t) if (t < ntn) { const float dm = mt[t] - mean; q += m2[t] + 256.0f * dm * dm; }
            S[row] = (f32x2v){mean, 1.0f / sqrtf(q / (256.0f * (float)ntn) + eps)};
        }
        asm volatile("s_waitcnt lgkmcnt(0)" ::: "memory"); __builtin_amdgcn_s_barrier(); asm volatile("" ::: "memory");
        return bad;
    }
};
struct EpiLnRes {
    static constexpr bool PERM = false, AFTER_DRAIN = true;
    const float* base; float* out; int ldc; const float* bias; PanelStats st; unsigned poison;
    __device__ __forceinline__ void fused(f32x4 (&acc)[2][2][4][2], const Unit& u, int wr, int wc, int fr, int fq, PG8_LAS unsigned char* lds, int wid, int lane) const {
        typedef float f32x2v __attribute__((ext_vector_type(2)));
        const PG8_LAS f32x2v* S = (const PG8_LAS f32x2v*)(lds + 8192);
        const int col0 = u.pn * BM + wc * 32 + 4 * fq;
#pragma unroll
        for (int bj = 0; bj < 2; ++bj)
#pragma unroll
            for (int n = 0; n < 2; ++n) { const f32x4 bv = bias ? *(const f32x4*)(bias + col0 + bj * HALF + n * 16) : (f32x4){0.f, 0.f, 0.f, 0.f};
#pragma unroll
                for (int ai = 0; ai < 2; ++ai)
#pragma unroll
                    for (int m = 0; m < 4; ++m) acc[ai][bj][m][n] += bv; }
        f32x4 pre[4][2][2];
#pragma unroll
        for (int m = 0; m < 4; ++m) { const size_t off = (size_t)(u.pm * BM + wr * 64 + m * 16 + fr) * ldc + col0;
#pragma unroll
            for (int bj = 0; bj < 2; ++bj)
#pragma unroll
                for (int n = 0; n < 2; ++n) pre[m][bj][n] = *(const f32x4*)(base + off + bj * HALF + n * 16); }
        const bool bad = st.run(acc, u, wr, wc, fr, fq, lds, wid, lane) || poison != 0u;
        const float qnan = __builtin_nanf("");
#pragma unroll
        for (int ai = 0; ai < 2; ++ai)
#pragma unroll
            for (int m = 0; m < 4; ++m) { const int r = ai * HALF + wr * 64 + m * 16 + fr; const f32x2v sr = S[r]; const size_t off = (size_t)(u.pm * BM + r) * ldc + col0;
#pragma unroll
                for (int bj = 0; bj < 2; ++bj)
#pragma unroll
                    for (int n = 0; n < 2; ++n) { const f32x4 bs = ai == 0 ? pre[m][bj][n] : *(const f32x4*)(base + off + bj * HALF + n * 16); f32x4 o = bs + (acc[ai][bj][m][n] - sr.x) * sr.y;
                        if (bad) o = (f32x4){qnan, qnan, qnan, qnan}; *(f32x4*)(out + off + bj * HALF + n * 16) = o; }
                if (m & 1) asm volatile("" ::: "memory"); }
    }
};
struct EpiLnResLn {
    static constexpr bool PERM = false, AFTER_DRAIN = true;
    const float* base; float* out; bf16_t* xn; int ldc; const float* bias; PanelStats st1, st2; unsigned poison;
    __device__ __forceinline__ void fused(f32x4 (&acc)[2][2][4][2], const Unit& u, int wr, int wc, int fr, int fq, PG8_LAS unsigned char* lds, int wid, int lane) const {
        typedef float f32x2v __attribute__((ext_vector_type(2))); typedef unsigned u32x2v __attribute__((ext_vector_type(2)));
        const PG8_LAS f32x2v* S = (const PG8_LAS f32x2v*)(lds + 8192);
        const int col0 = u.pn * BM + wc * 32 + 4 * fq;
#pragma unroll
        for (int bj = 0; bj < 2; ++bj)
#pragma unroll
            for (int n = 0; n < 2; ++n) { const f32x4 bv = bias ? *(const f32x4*)(bias + col0 + bj * HALF + n * 16) : (f32x4){0.f, 0.f, 0.f, 0.f};
#pragma unroll
                for (int ai = 0; ai < 2; ++ai)
#pragma unroll
                    for (int m = 0; m < 4; ++m) acc[ai][bj][m][n] += bv; }
        bool bad = st1.run(acc, u, wr, wc, fr, fq, lds, wid, lane) || poison != 0u;
        const float qnan = __builtin_nanf("");
#pragma unroll
        for (int ai = 0; ai < 2; ++ai)
#pragma unroll
            for (int m = 0; m < 4; ++m) { const int r = ai * HALF + wr * 64 + m * 16 + fr; const f32x2v sr = S[r]; const size_t off = (size_t)(u.pm * BM + r) * ldc + col0;
#pragma unroll
                for (int bj = 0; bj < 2; ++bj)
#pragma unroll
                    for (int n = 0; n < 2; ++n) { const f32x4 bs = *(const f32x4*)(base + off + bj * HALF + n * 16); acc[ai][bj][m][n] = bs + (acc[ai][bj][m][n] - sr.x) * sr.y; }
                asm volatile("" : "+v"(acc[ai][0][m][0]), "+v"(acc[ai][0][m][1]), "+v"(acc[ai][1][m][0]), "+v"(acc[ai][1][m][1]));
                if (m & 1) asm volatile("" ::: "memory"); }
        const bool bad1 = bad;
        bad = st2.run(acc, u, wr, wc, fr, fq, lds, wid, lane) || bad;
#pragma unroll
        for (int ai = 0; ai < 2; ++ai)
#pragma unroll
            for (int m = 0; m < 4; ++m) { const int r = ai * HALF + wr * 64 + m * 16 + fr; const f32x2v sr = S[r]; const size_t off = (size_t)(u.pm * BM + r) * ldc + col0;
#pragma unroll
                for (int bj = 0; bj < 2; ++bj)
#pragma unroll
                    for (int n = 0; n < 2; ++n) { const f32x4 x1 = acc[ai][bj][m][n]; *(f32x4*)(out + off + bj * HALF + n * 16) = bad1 ? (f32x4){qnan, qnan, qnan, qnan} : x1;
                        const f32x4 o = (x1 - sr.x) * sr.y; u32x2v w; w.x = cvt_pk_bf16(o[0], o[1]); w.y = cvt_pk_bf16(o[2], o[3]);
                        if (bad) { w.x = 0x7fc07fc0u; w.y = 0x7fc07fc0u; } *(u32x2v*)(xn + off + bj * HALF + n * 16) = w; }
                asm volatile("" ::: "memory"); }
    }
};

template <class Epi, class Sched, bool ALIGN_EPI = false, bool SP2 = false>
__device__ __forceinline__ void gemm_phase(PG8_LAS unsigned char* lds, const unsigned lda2, const unsigned ldb2, const Sched& S, const Epi& E) {
    int tid_ = threadIdx.x; asm volatile("" : "+v"(tid_));
    const int tid = tid_, wid = __builtin_amdgcn_readfirstlane(tid >> 6), lane = tid & 63, wr = wid >> 2, wc = wid & 3, fr = lane & 15, fq = lane >> 4;
    unsigned voffA[2], voffB[2];
#pragma unroll
    for (int i = 0; i < 2; ++i) { int R, C; stage_rc(tid * 16 + i * 8192, R, C); const int Rb = Epi::PERM ? ((R & ~31) + perm32(R & 31)) : R;
        voffA[i] = (unsigned)R * lda2 + (unsigned)C * 2u; voffB[i] = (unsigned)Rb * ldb2 + (unsigned)C * 2u; }
    const size_t kstep = (size_t)(BK * 2);
    const size_t hstepA = (size_t)HALF * lda2, hstepB = (size_t)HALF * ldb2;
    const unsigned ldsw = (unsigned)wid * 1024u;
    const int aoff = lds_byte(wr * 64 + fr, fq * 8), boff = lds_byte(wc * 32 + fr, fq * 8);
#define PG8_SA(b, h) (((b) * 2 + (h)) * HTB)
#define PG8_SB(b, h) ((4 + (b) * 2 + (h)) * HTB)
#define PG8_STAGE(bufoff, gbase, voff) do { _Pragma("unroll") for (int _i = 0; _i < 2; ++_i) \
        __builtin_amdgcn_global_load_lds((const unsigned*)((const char*)(gbase) + (voff)[_i]), (PG8_LAS unsigned*)(lds + (bufoff) + ldsw + _i * 8192), 16, 0, 0); } while (0)
#define PG8_LDA(dst, b, h) do { _Pragma("unroll") for (int m = 0; m < 4; ++m) _Pragma("unroll") for (int k = 0; k < 2; ++k) dst[m][k] = *(const PG8_LAS bf16x8*)(lds + PG8_SA(b, h) + aoff + m * 2048 + k * 1024); } while (0)
#define PG8_LDB(dst, b, h) do { _Pragma("unroll") for (int n = 0; n < 2; ++n) _Pragma("unroll") for (int k = 0; k < 2; ++k) dst[n][k] = *(const PG8_LAS bf16x8*)(lds + PG8_SB(b, h) + boff + n * 2048 + k * 1024); } while (0)
#define PG8_MMA(ai, bj, At, Bt) do { __builtin_amdgcn_s_setprio(1); _Pragma("unroll") for (int m = 0; m < 4; ++m) _Pragma("unroll") for (int n = 0; n < 2; ++n) _Pragma("unroll") for (int k = 0; k < 2; ++k) \
        acc[ai][bj][m][n] = __builtin_amdgcn_mfma_f32_16x16x32_bf16(Bt[n][k], At[m][k], acc[ai][bj][m][n], 0, 0, 0); __builtin_amdgcn_s_setprio(0); } while (0)
#define PG8_WAIT_V(n) asm volatile("s_waitcnt vmcnt(" #n ")" ::: "memory")
#define PG8_WAIT_L(n) asm volatile("s_waitcnt lgkmcnt(" #n ")" ::: "memory")
#define PG8_BAR __builtin_amdgcn_s_barrier()
#define PG8_SCHED __builtin_amdgcn_sched_barrier(0)
    Unit cur, nxt; int ui = 0;
    if (!S.next(0, cur)) return;
    f32x4 acc[2][2][4][2];
#pragma unroll
    for (int a = 0; a < 2; ++a)
#pragma unroll
        for (int b = 0; b < 2; ++b)
#pragma unroll
            for (int m = 0; m < 4; ++m)
#pragma unroll
                for (int n = 0; n < 2; ++n) acc[a][b][m][n] = (f32x4){0.f, 0.f, 0.f, 0.f};
    bf16x8 At[4][2], B0[2][2], B1[2][2];
    const char* cA = cur.A; const char* cB = cur.B;
    S.a_ready(cur);
    if constexpr (SP2) {
        PG8_STAGE(PG8_SB(0, 0), cB, voffB); PG8_STAGE(PG8_SB(0, 1), cB + hstepB, voffB); PG8_STAGE(PG8_SA(0, 0), cA, voffA); PG8_STAGE(PG8_SA(0, 1), cA + hstepA, voffA);
        if (wr == 1) PG8_BAR;
        PG8_WAIT_V(2); PG8_BAR;
        PG8_STAGE(PG8_SB(1, 0), cB + kstep, voffB); PG8_STAGE(PG8_SA(1, 0), cA + kstep, voffA); PG8_STAGE(PG8_SB(1, 1), cB + hstepB + kstep, voffB);
        PG8_WAIT_V(6); PG8_BAR;
    } else {
        PG8_STAGE(PG8_SB(0, 0), cB, voffB); PG8_STAGE(PG8_SA(0, 0), cA, voffA); PG8_STAGE(PG8_SB(0, 1), cB + hstepB, voffB); PG8_STAGE(PG8_SA(0, 1), cA + hstepA, voffA);
        if (wr == 1) PG8_BAR;
        PG8_WAIT_V(4); PG8_BAR;
        PG8_STAGE(PG8_SB(1, 0), cB + kstep, voffB); PG8_STAGE(PG8_SA(1, 0), cA + kstep, voffA); PG8_STAGE(PG8_SB(1, 1), cB + hstepB + kstep, voffB);
        PG8_WAIT_V(6); PG8_BAR;
    }
    for (;;) {
        const bool has_next = S.next(ui + 1, nxt);
        const char* nA = has_next ? nxt.A : cA; const char* nB = has_next ? nxt.B : cB;
        const int nt = cur.nt;
        for (int t = 0; t < nt; t += 2) {
            const bool last = (t == nt - 2);
            const char* a1 = cA + (size_t)(t + 1) * kstep;
            const char* a2 = last ? nA : cA + (size_t)(t + 2) * kstep; const char* b2 = last ? nB : cB + (size_t)(t + 2) * kstep;
            const char* a3 = a2 + kstep; const char* b3 = b2 + kstep;
            if (last && has_next) S.a_ready(nxt);
            if constexpr (SP2) {
            PG8_LDB(B0, 0, 0); PG8_LDB(B1, 0, 1); PG8_SCHED; PG8_LDA(At, 0, 0); PG8_STAGE(PG8_SA(1, 1), a1 + hstepA, voffA);
            PG8_WAIT_V(8); PG8_WAIT_L(0); PG8_BAR; PG8_MMA(0, 0, At, B0); PG8_MMA(0, 1, At, B1); PG8_BAR; PG8_SCHED;
            PG8_LDA(At, 0, 1); PG8_STAGE(PG8_SB(0, 0), b2, voffB); PG8_STAGE(PG8_SB(0, 1), b2 + hstepB, voffB); PG8_STAGE(PG8_SA(0, 0), a2, voffA);
            PG8_WAIT_V(8); PG8_WAIT_L(0); PG8_BAR; PG8_MMA(1, 0, At, B0); PG8_MMA(1, 1, At, B1); PG8_BAR; PG8_SCHED;
            PG8_LDB(B0, 1, 0); PG8_LDB(B1, 1, 1); PG8_SCHED; PG8_LDA(At, 1, 0); PG8_STAGE(PG8_SA(0, 1), a2 + hstepA, voffA);
            PG8_WAIT_V(8); PG8_WAIT_L(0); PG8_BAR; PG8_MMA(0, 0, At, B0); PG8_MMA(0, 1, At, B1); PG8_BAR; PG8_SCHED;
            PG8_LDA(At, 1, 1); PG8_STAGE(PG8_SB(1, 0), b3, voffB); PG8_STAGE(PG8_SB(1, 1), b3 + hstepB, voffB); PG8_STAGE(PG8_SA(1, 0), a3, voffA);
            PG8_WAIT_V(8); PG8_WAIT_L(0); PG8_BAR; PG8_MMA(1, 0, At, B0); PG8_MMA(1, 1, At, B1); PG8_BAR; PG8_SCHED;
            } else {
            PG8_LDB(B0, 0, 0); PG8_SCHED; PG8_LDA(At, 0, 0); PG8_STAGE(PG8_SA(1, 1), a1 + hstepA, voffA);
            PG8_WAIT_L(8); PG8_BAR; PG8_WAIT_L(0); PG8_MMA(0, 0, At, B0); PG8_BAR; PG8_SCHED;
            PG8_LDB(B1, 0, 1); PG8_STAGE(PG8_SB(0, 0), b2, voffB);
            PG8_BAR; PG8_WAIT_L(0); PG8_MMA(0, 1, At, B1); PG8_BAR;
            PG8_LDA(At, 0, 1); PG8_STAGE(PG8_SA(0, 0), a2, voffA);
            PG8_BAR; PG8_WAIT_L(0); PG8_MMA(1, 0, At, B0); PG8_BAR; PG8_SCHED;
            PG8_STAGE(PG8_SB(0, 1), b2 + hstepB, voffB);
            PG8_WAIT_V(6); PG8_BAR; PG8_MMA(1, 1, At, B1); PG8_BAR;
            PG8_LDB(B0, 1, 0); PG8_SCHED; PG8_LDA(At, 1, 0); PG8_STAGE(PG8_SA(0, 1), a2 + hstepA, voffA);
            PG8_WAIT_L(8); PG8_BAR; PG8_WAIT_L(0); PG8_MMA(0, 0, At, B0); PG8_BAR; PG8_SCHED;
            PG8_LDB(B1, 1, 1); PG8_STAGE(PG8_SB(1, 0), b3, voffB);
            PG8_BAR; PG8_WAIT_L(0); PG8_MMA(0, 1, At, B1); PG8_BAR;
            PG8_LDA(At, 1, 1); PG8_STAGE(PG8_SA(1, 0), a3, voffA);
            PG8_BAR; PG8_WAIT_L(0); PG8_MMA(1, 0, At, B0); PG8_BAR; PG8_SCHED;
            PG8_STAGE(PG8_SB(1, 1), b3 + hstepB, voffB);
            PG8_WAIT_V(6); PG8_BAR; PG8_MMA(1, 1, At, B1); PG8_BAR;
            }
        }
        if constexpr (ALIGN_EPI) { if (wr == 0) PG8_BAR; }
        if constexpr (!Epi::AFTER_DRAIN) { E(acc, cur, wr, wc, fr, fq); S.done(cur); }
        if (!has_next) break;
#pragma unroll
        for (int a = 0; a < 2; ++a)
#pragma unroll
            for (int b = 0; b < 2; ++b)
#pragma unroll
                for (int m = 0; m < 4; ++m)
#pragma unroll
                    for (int n = 0; n < 2; ++n) acc[a][b][m][n] = (f32x4){0.f, 0.f, 0.f, 0.f};
        cur = nxt; cA = nA; cB = nB; ++ui;
        if constexpr (ALIGN_EPI) { if (wr == 1) PG8_BAR; }
    }
    PG8_WAIT_V(0);
    if constexpr (!ALIGN_EPI) { if (wr == 0) PG8_BAR; }
    PG8_BAR;
    if constexpr (Epi::AFTER_DRAIN) { E.fused(acc, cur, wr, wc, fr, fq, lds, wid, lane); S.done(cur); }
#undef PG8_SA
#undef PG8_SB
#undef PG8_STAGE
#undef PG8_LDA
#undef PG8_LDB
#undef PG8_MMA
#undef PG8_WAIT_V
#undef PG8_WAIT_L
#undef PG8_BAR
#undef PG8_SCHED
}
}
#define GAS __attribute__((address_space(1)))
#define LAS __attribute__((address_space(3)))
typedef unsigned short bf16;
typedef unsigned v4u __attribute__((ext_vector_type(4)));
typedef float f32x4 __attribute__((ext_vector_type(4)));
typedef short bf16x8 __attribute__((ext_vector_type(8)));
typedef GAS unsigned gu32;
typedef GAS unsigned long long gu64;
#define RLX_AGENT __ATOMIC_RELAXED, __HIP_MEMORY_SCOPE_AGENT
#define LDS_WAIT() asm volatile("s_waitcnt lgkmcnt(0)" ::: "memory")
#define VM_WAIT() asm volatile("s_waitcnt vmcnt(0)" ::: "memory")
__device__ __forceinline__ unsigned long long rt() { return __builtin_amdgcn_s_memrealtime(); }
__device__ __forceinline__ unsigned f2bf(float f) { unsigned u = __builtin_bit_cast(unsigned, f); return (u + 0x7fffu + ((u >> 16) & 1u)) >> 16; }
__device__ __forceinline__ unsigned pk2(float lo, float hi) { return f2bf(lo) | (f2bf(hi) << 16); }

#define XB_TMO      128
#define XB_XCNT(j)  (256  + 64 * (j))
#define XB_XSUB(j)  (1280 + 64 * (j))
#define XB_XGEN(j)  (2304 + 64 * (j))
#define XB_TOP      3328
#define XB_TOPGEN   3392
#define XCD_BAR_WORDS 3456
#define XB_SPIN_CAP (1u << 18)

__device__ __forceinline__ unsigned xb_ld(unsigned* p)              { return __hip_atomic_load(p, __ATOMIC_RELAXED, __HIP_MEMORY_SCOPE_AGENT); }
__device__ __forceinline__ unsigned xb_add(unsigned* p, unsigned v) { return __hip_atomic_fetch_add(p, v, __ATOMIC_RELAXED, __HIP_MEMORY_SCOPE_AGENT); }
__device__ __forceinline__ unsigned xb_xcc_id() { return (unsigned)__builtin_amdgcn_s_getreg((3 << 11) | 20) & 0xFu; }
#define XB_SPIN(cond, bar) do { unsigned _sp = 0; while (cond) { __builtin_amdgcn_s_sleep(1); \
    if ((++_sp & 255u) == 0u) { if (xb_ld(&(bar)[XB_TMO])) break; if (_sp > XB_SPIN_CAP) { atomicAdd(&(bar)[XB_TMO], 1u); break; } } } } while (0)

struct XcdBarrier {
    unsigned* bar; unsigned x;
    volatile LAS unsigned* st;
};

__device__ __forceinline__ XcdBarrier xcd_barrier_post(unsigned* bar, volatile LAS unsigned* st) {
    XcdBarrier b; b.bar = bar; b.x = xb_xcc_id(); b.st = st;
    if (threadIdx.x == 0) (void)xb_add(&bar[XB_XCNT(b.x)], 1u);
    return b;
}
__device__ __forceinline__ void xcd_barrier_complete(unsigned* bar, unsigned x, unsigned& nloc, unsigned& nx) {
    const unsigned G = gridDim.x * gridDim.y * gridDim.z;
    asm volatile("" : "+s"(x));
    unsigned sum, cnt, mine, sp = 0u;
    for (;;) {
        sum = 0u; cnt = 0u; mine = 0u;
#pragma unroll
        for (unsigned j = 0; j < 16; ++j) { const unsigned c = xb_ld(&bar[XB_XCNT(j)]); sum += c; cnt += (c > 0u) ? 1u : 0u; mine = (j == x) ? c : mine; }
        if (sum == G) break;
        __builtin_amdgcn_s_sleep(1);
        if ((++sp & 255u) == 0u) { if (xb_ld(&bar[XB_TMO])) break; if (sp > XB_SPIN_CAP) { atomicAdd(&bar[XB_TMO], 1u); break; } }
    }
    nloc = mine > 0u ? mine : 1u; nx = cnt > 0u ? cnt : 1u;
}

__device__ __forceinline__ void xcd_barrier(const XcdBarrier& b) {
    asm volatile("s_waitcnt vmcnt(0)" ::: "memory");
    __syncthreads();
    if (threadIdx.x == 0) {
        unsigned* bar = b.bar;
        __builtin_amdgcn_s_waitcnt(0);
        unsigned nloc = b.st[0], nx = b.st[1];
        if (nloc == 0u) { xcd_barrier_complete(bar, b.x, nloc, nx); b.st[0] = nloc; b.st[1] = nx; }
        const unsigned old = xb_add(&bar[XB_XSUB(b.x)], 1u);
        const unsigned gen = old / nloc;
        if (old + 1u == (gen + 1u) * nloc) {
            __builtin_amdgcn_fence(__ATOMIC_RELEASE, "agent");
            asm volatile("s_waitcnt vmcnt(0)" ::: "memory");
            const unsigned og = xb_add(&bar[XB_TOP], 1u);
            const unsigned tg = og / nx;
            if (og + 1u == (tg + 1u) * nx) xb_add(&bar[XB_TOPGEN], 1u);
            else XB_SPIN(xb_ld(&bar[XB_TOPGEN]) == tg, bar);
            __builtin_amdgcn_fence(__ATOMIC_ACQUIRE, "agent");
            xb_add(&bar[XB_XGEN(b.x)], 1u);
            asm volatile("s_waitcnt vmcnt(0)" ::: "memory");
        } else {
            XB_SPIN(xb_ld(&bar[XB_XGEN(b.x)]) == gen, bar);
            __builtin_amdgcn_fence(__ATOMIC_ACQUIRE, "agent");
            asm volatile("s_waitcnt vmcnt(0)" ::: "memory");
        }
    }
    __syncthreads();
}

constexpr int NWAVES = 8;
constexpr int BATCH = 4, SEQ = 4096, D = 1024, DEPTH = 4, FF = 4096, PLE = 256;
constexpr int M = BATCH * SEQ;
constexpr float ALPHA = 1.681792830507429f;
constexpr float LN_EPS = 1e-5f;
constexpr size_t MiB = 1u << 20;
constexpr size_t WS_CTL = 0, CTL_ZERO_BYTES = 1 * MiB;
constexpr size_t WS_WMIX = 2 * MiB;
constexpr size_t WS_WCOM = 17 * MiB;
constexpr size_t WS_WUP = WS_WCOM, WS_WDOWN = WS_WCOM + 8 * MiB, WS_WGATE = WS_WCOM + 16 * MiB, WS_WPROJ = WS_WCOM + 18 * MiB;
constexpr size_t WS_HB = 37 * MiB;
constexpr int HB_ROWS = SEQ + 1;
constexpr size_t WS_SCR = 70 * MiB;
constexpr size_t WS_HID = WS_SCR;
constexpr size_t WS_PP = WS_SCR + 128 * MiB;
constexpr size_t WS_PB = WS_SCR + 160 * MiB;
constexpr size_t WS_END_MIN = WS_SCR + 256 * MiB;
constexpr int CW_TMO = 0, CW_CODE = 1, CW_BAR = 4096;

constexpr int RING_OFF = 0, RING_BYTES = 131072;
constexpr int LDSCTL_OFF = RING_BYTES, MISC_OFF = LDSCTL_OFF + 320;
constexpr int LDS_BYTES = 147456;

struct Frame {
    LAS unsigned char* lds;
    volatile LAS unsigned* MISC;
    gu32* ctl;
    int tid, lane, wave;
    int vcu, G;
    unsigned char* ws;
    float* H;
};
__device__ __forceinline__ bf16* hb_row(unsigned char* ws, int m) { const int b = m >> 12, t = m & 4095; return (bf16*)(ws + WS_HB) + ((size_t)b * HB_ROWS + 1 + t) * D; }
__device__ __forceinline__ const char* hb_tile(unsigned char* ws, int pm) { return (const char*)hb_row(ws, pm * 256); }

__device__ __forceinline__ float wave_sum(float v) {
#pragma unroll
    for (int o = 1; o < 64; o <<= 1) v += __shfl_xor(v, o);
    return v;
}
__device__ __forceinline__ float sigmoidf_(float x) { return 1.f / (1.f + __expf(-x)); }

struct PD { int nN, nt; long a_off, a_tile, b_off, b_tile; };
constexpr PD mkpd(int N, int K, long a_off, long lda2, long b_off, long ldb2) { return PD{N / 256, K / 64, a_off, 256 * lda2, b_off, 256 * ldb2}; }
template <class Cfg> struct SchedC {
    unsigned char* ws; int G, c;
    __device__ __forceinline__ bool next(int i, pg8::Unit& u) const {
        int L = i * G + c; int gi = 0;
        constexpr int n0 = 64 * Cfg::p0.nN, n1 = Cfg::np > 1 ? 64 * Cfg::p1.nN : 0, n2 = Cfg::np > 2 ? 64 * Cfg::p2.nN : 0;
        if (L >= n0 + n1 + n2) return false;
        if (Cfg::np > 1 && L >= n0) { L -= n0; gi = 1; if (Cfg::np > 2 && L >= n1) { L -= n1; gi = 2; } }
        const int nN = gi == 0 ? Cfg::p0.nN : gi == 1 ? Cfg::p1.nN : Cfg::p2.nN;
        const int q = 8 * nN, wgid = (L % 8) * q + L / 8;
        const int nig = 8 * nN, fm = (wgid / nig) * 8;
        u.pm = fm + ((wgid % nig) % 8); u.pn = (wgid % nig) / 8; u.gi = gi;
        u.nt = gi == 0 ? Cfg::p0.nt : gi == 1 ? Cfg::p1.nt : Cfg::p2.nt;
        const long a_off = gi == 0 ? Cfg::p0.a_off : gi == 1 ? Cfg::p1.a_off : Cfg::p2.a_off, a_tile = gi == 0 ? Cfg::p0.a_tile : gi == 1 ? Cfg::p1.a_tile : Cfg::p2.a_tile;
        const long b_off = gi == 0 ? Cfg::p0.b_off : gi == 1 ? Cfg::p1.b_off : Cfg::p2.b_off, b_tile = gi == 0 ? Cfg::p0.b_tile : gi == 1 ? Cfg::p1.b_tile : Cfg::p2.b_tile;
        u.A = a_off >= 0 ? (const char*)ws + a_off + (long)u.pm * a_tile : (a_off == -2 ? hb_tile(ws, u.pm) - 2048 : hb_tile(ws, u.pm));
        u.B = (const char*)ws + b_off + (long)u.pn * b_tile;
        u.pm = __builtin_amdgcn_readfirstlane(u.pm); u.pn = __builtin_amdgcn_readfirstlane(u.pn); u.gi = __builtin_amdgcn_readfirstlane(u.gi); u.nt = __builtin_amdgcn_readfirstlane(u.nt);
        { const unsigned long long a_ = (unsigned long long)u.A, b_ = (unsigned long long)u.B;
          u.A = (const char*)(((unsigned long long)(unsigned)__builtin_amdgcn_readfirstlane((unsigned)(a_ >> 32)) << 32) | (unsigned)__builtin_amdgcn_readfirstlane((unsigned)a_));
          u.B = (const char*)(((unsigned long long)(unsigned)__builtin_amdgcn_readfirstlane((unsigned)(b_ >> 32)) << 32) | (unsigned)__builtin_amdgcn_readfirstlane((unsigned)b_)); }
        return true;
    }
    __device__ __forceinline__ void a_ready(const pg8::Unit&) const {}
    __device__ __forceinline__ void done(const pg8::Unit&) const {}
};
using pg8::f32x4; using pg8::bf16_t; using pg8::u32x4; using pg8::Unit; using pg8::cvt_pk_bf16;
typedef unsigned u32x2 __attribute__((ext_vector_type(2)));

struct ConvJob { const float* W; const float* sc; bf16* WT; int K, N, row_off, ldt, k_off, scmode, nitems, pad; };
constexpr int JOB_OFF = RING_BYTES + 1024, MAX_JOBS = 32;
static_assert(JOB_OFF + MAX_JOBS * 64 + 64 <= LDS_BYTES, "job table");

__device__ __forceinline__ void conv_item(const ConvJob& J, LAS float* scr, int item, int lane) {
    const int nblk = J.N / 32, kb = item / nblk, nb = item % nblk, k0 = 64 * kb, n0 = 32 * nb;
    if (J.W) {
#pragma unroll 8
        for (int i = 0; i < 32; ++i) { const int kk = 2 * i + (lane >> 5); float v = J.W[(size_t)(k0 + kk) * J.N + n0 + (lane & 31)];
            if (J.sc) { const float s = J.sc[k0 + kk]; v *= J.scmode ? (1.f - s) : s; }
            scr[kk * 33 + (lane & 31)] = v; }
    } else {
#pragma unroll 8
        for (int i = 0; i < 32; ++i) { const int kk = 2 * i + (lane >> 5); scr[kk * 33 + (lane & 31)] = 0.f; }
    }
    LDS_WAIT(); asm volatile("" ::: "memory");
    const int c = lane & 7;
#pragma unroll
    for (int j = 0; j < 4; ++j) { const int n = (lane >> 3) + 8 * j; const LAS float* s = scr + (8 * c) * 33 + n;
        v4u o; o.x = pk2(s[0 * 33], s[1 * 33]); o.y = pk2(s[2 * 33], s[3 * 33]); o.z = pk2(s[4 * 33], s[5 * 33]); o.w = pk2(s[6 * 33], s[7 * 33]);
        *(GAS v4u*)(J.WT + (size_t)(J.row_off + n0 + n) * J.ldt + J.k_off + k0 + 8 * c) = o; }
    LDS_WAIT(); asm volatile("" ::: "memory");
}
__device__ __forceinline__ void conv_run(Frame& F, int njobs) {
    const LAS unsigned* jw = (const LAS unsigned*)(F.lds + JOB_OFF);
    LAS float* scr = (LAS float*)(F.lds + RING_OFF + F.wave * 16384);
    const int gw = F.vcu * NWAVES + F.wave, NGW = F.G * NWAVES;
    int base = 0;
    for (int j = 0; j < njobs; ++j) {
        const LAS unsigned* w = jw + 16 * j;
        ConvJob J;
        J.W = (const float*)(((unsigned long long)__builtin_amdgcn_readfirstlane(w[1]) << 32) | (unsigned)__builtin_amdgcn_readfirstlane(w[0]));
        J.sc = (const float*)(((unsigned long long)__builtin_amdgcn_readfirstlane(w[3]) << 32) | (unsigned)__builtin_amdgcn_readfirstlane(w[2]));
        J.WT = (bf16*)(((unsigned long long)__builtin_amdgcn_readfirstlane(w[5]) << 32) | (unsigned)__builtin_amdgcn_readfirstlane(w[4]));
        J.K = __builtin_amdgcn_readfirstlane(w[6]); J.N = __builtin_amdgcn_readfirstlane(w[7]); J.row_off = __builtin_amdgcn_readfirstlane(w[8]); J.ldt = __builtin_amdgcn_readfirstlane(w[9]);
        J.k_off = __builtin_amdgcn_readfirstlane(w[10]); J.scmode = __builtin_amdgcn_readfirstlane(w[11]); J.nitems = __builtin_amdgcn_readfirstlane(w[12]); J.pad = 0;
        const int first = (gw - base % NGW + NGW) % NGW;
        for (int it = first; it < J.nitems; it += NGW) conv_item(J, scr, it, F.lane);
        base += J.nitems;
    }
}
__device__ __forceinline__ void put_job(Frame& F, int& n, const float* W, int K, int N, bf16* WT, int row_off, int ldt, int k_off, const float* sc = nullptr, int scmode = 0) {
    LAS unsigned* w = (LAS unsigned*)(F.lds + JOB_OFF) + 16 * n;
    w[0] = (unsigned)(unsigned long long)W; w[1] = (unsigned)((unsigned long long)W >> 32); w[2] = (unsigned)(unsigned long long)sc; w[3] = (unsigned)((unsigned long long)sc >> 32);
    w[4] = (unsigned)(unsigned long long)WT; w[5] = (unsigned)((unsigned long long)WT >> 32);
    w[6] = K; w[7] = N; w[8] = row_off; w[9] = ldt; w[10] = k_off; w[11] = scmode; w[12] = (K / 64) * (N / 32);
    ++n;
}

__device__ __forceinline__ void pb_phase(Frame& F, const float* p_layer) {
    const int gw = F.vcu * NWAVES + F.wave, NGW = F.G * NWAVES;
    bf16* PB = (bf16*)(F.ws + WS_PB);
    for (int m = gw; m < M; m += NGW) {
        const f32x4 v = *((const GAS f32x4*)(p_layer + (size_t)m * PLE) + F.lane);
        u32x2 o; o.x = pk2(v.x, v.y); o.y = pk2(v.z, v.w);
        *((GAS u32x2*)(PB + (size_t)m * 1024) + F.lane) = o;
    }
}
__device__ __forceinline__ void init_phase(Frame& F, const float* x) {
    const int gw = F.vcu * NWAVES + F.wave, NGW = F.G * NWAVES;
    for (int m = gw; m < M; m += NGW) {
        const GAS f32x4* xr = (const GAS f32x4*)(x + (size_t)m * D) + F.lane; GAS f32x4* hr = (GAS f32x4*)(F.H + (size_t)m * D) + F.lane;
        GAS u32x2* o8 = (GAS u32x2*)hb_row(F.ws, m) + F.lane;
#pragma unroll
        for (int j = 0; j < 4; ++j) { const f32x4 v = xr[64 * j]; hr[64 * j] = v; u32x2 o; o.x = pk2(v.x, v.y); o.y = pk2(v.z, v.w); o8[64 * j] = o; }
    }
    if (gw < BATCH) { GAS u32x2* o8 = (GAS u32x2*)((bf16*)(F.ws + WS_HB) + (size_t)gw * HB_ROWS * D) + F.lane;
#pragma unroll
        for (int j = 0; j < 4; ++j) o8[64 * j] = (u32x2){0u, 0u}; }
}
__device__ __forceinline__ void ln_phase(Frame& F, const float* g, const float* b) {
    const int gw = F.vcu * NWAVES + F.wave, NGW = F.G * NWAVES;
    f32x4 gv[4], bv[4];
#pragma unroll
    for (int j = 0; j < 4; ++j) { gv[j] = *((const GAS f32x4*)g + F.lane + 64 * j); bv[j] = *((const GAS f32x4*)b + F.lane + 64 * j); }
    for (int m = gw; m < M; m += NGW) {
        GAS f32x4* hr = (GAS f32x4*)(F.H + (size_t)m * D) + F.lane;
        f32x4 v[4]; float s = 0.f;
#pragma unroll
        for (int j = 0; j < 4; ++j) { v[j] = hr[64 * j]; s += (v[j].x + v[j].y) + (v[j].z + v[j].w); }
        const float mean = wave_sum(s) * (1.f / D); float s2 = 0.f;
#pragma unroll
        for (int j = 0; j < 4; ++j) { v[j] = v[j] - mean; s2 += (v[j].x * v[j].x + v[j].y * v[j].y) + (v[j].z * v[j].z + v[j].w * v[j].w); }
        const float rstd = 1.f / sqrtf(wave_sum(s2) * (1.f / D) + LN_EPS);
        GAS u32x2* o8 = (GAS u32x2*)hb_row(F.ws, m) + F.lane;
#pragma unroll
        for (int j = 0; j < 4; ++j) { const f32x4 o = v[j] * rstd * gv[j] + bv[j]; hr[64 * j] = o; u32x2 w; w.x = pk2(o.x, o.y); w.y = pk2(o.z, o.w); o8[64 * j] = w; }
    }
}

#define EPI_LOOP_BEGIN const int row0 = u.pm * 256 + wr * 64 + fr; const int col0 = u.pn * 256 + wc * 32 + 8 * fq; \
    _Pragma("unroll") for (int ai = 0; ai < 2; ++ai) _Pragma("unroll") for (int m = 0; m < 4; ++m) { const int row = row0 + ai * 128 + m * 16; \
    _Pragma("unroll") for (int bj = 0; bj < 2; ++bj) { const int col = col0 + bj * 128; f32x4 v0 = acc[ai][bj][m][0], v1 = acc[ai][bj][m][1];
#define EPI_LOOP_END } __builtin_amdgcn_sched_barrier(0); }
__device__ __forceinline__ u32x4 pack8(const f32x4& v0, const f32x4& v1) { u32x4 w; w.x = cvt_pk_bf16(v0[0], v0[1]); w.y = cvt_pk_bf16(v0[2], v0[3]); w.z = cvt_pk_bf16(v1[0], v1[1]); w.w = cvt_pk_bf16(v1[2], v1[3]); return w; }

struct EpiUpPP {
    static constexpr bool PERM = true, AFTER_DRAIN = false;
    unsigned char* ws;
    __device__ __forceinline__ void operator()(const f32x4 (&acc)[2][2][4][2], const Unit& u, int wr, int wc, int fr, int fq) const {
        const bool up = (u.gi == 0); bf16_t* base = (bf16_t*)(ws + (up ? WS_HID : WS_PP)); const int ldc = up ? FF : D;
        EPI_LOOP_BEGIN
            if (up) { v0 = __builtin_elementwise_max(v0, (f32x4){0.f, 0.f, 0.f, 0.f}); v1 = __builtin_elementwise_max(v1, (f32x4){0.f, 0.f, 0.f, 0.f}); v0 = v0 * v0; v1 = v1 * v1; }
            *(u32x4*)(base + (size_t)row * ldc + col) = pack8(v0, v1);
        EPI_LOOP_END
    }
};
struct EpiResid {
    static constexpr bool PERM = true, AFTER_DRAIN = false;
    float* H;
    __device__ __forceinline__ void operator()(const f32x4 (&acc)[2][2][4][2], const Unit& u, int wr, int wc, int fr, int fq) const {
        EPI_LOOP_BEGIN
            f32x4* p = (f32x4*)(H + (size_t)row * D + col);
            const f32x4 h0 = p[0], h1 = p[1];
            p[0] = h0 * ALPHA + v0; p[1] = h1 * ALPHA + v1;
        EPI_LOOP_END
    }
};
struct EpiGate {
    static constexpr bool PERM = true, AFTER_DRAIN = false;
    float* H; unsigned char* ws;
    __device__ __forceinline__ void operator()(const f32x4 (&acc)[2][2][4][2], const Unit& u, int wr, int wc, int fr, int fq) const {
        EPI_LOOP_BEGIN
            f32x4* p = (f32x4*)(H + (size_t)row * D + col);
            const u32x4 pp = *(const u32x4*)((const bf16_t*)(ws + WS_PP) + (size_t)row * D + col);
            f32x4 h0 = p[0], h1 = p[1];
            f32x4 q0, q1;
            q0[0] = __uint_as_float(pp.x << 16); q0[1] = __uint_as_float(pp.x & 0xffff0000u); q0[2] = __uint_as_float(pp.y << 16); q0[3] = __uint_as_float(pp.y & 0xffff0000u);
            q1[0] = __uint_as_float(pp.z << 16); q1[1] = __uint_as_float(pp.z & 0xffff0000u); q1[2] = __uint_as_float(pp.w << 16); q1[3] = __uint_as_float(pp.w & 0xffff0000u);
#pragma unroll
            for (int e = 0; e < 4; ++e) { h0[e] += sigmoidf_(v0[e]) * q0[e]; h1[e] += sigmoidf_(v1[e]) * q1[e]; }
            p[0] = h0; p[1] = h1;
            *(u32x4*)(hb_row(ws, row) + col) = pack8(h0, h1);
        EPI_LOOP_END
    }
};

struct EpiQKV {
    static constexpr bool PERM = true, AFTER_DRAIN = false;
    unsigned char* ws; float qsc;
    __device__ __forceinline__ void operator()(const f32x4 (&acc)[2][2][4][2], const Unit& u_, int wr, int wc, int fr, int fq) const {
        const int which = u_.pn >> 2; Unit u = u_; u.pn &= 3;
        bf16_t* base = (bf16_t*)(ws + WS_SCR + (size_t)which * 32 * MiB); const float sc = which == 0 ? qsc : 1.f;
        EPI_LOOP_BEGIN
            v0 = v0 * sc; v1 = v1 * sc;
            *(u32x4*)(base + (size_t)row * D + col) = pack8(v0, v1);
        EPI_LOOP_END
    }
};

struct EpiGIN {
    static constexpr bool PERM = true, AFTER_DRAIN = false;
    unsigned char* ws;
    __device__ __forceinline__ void operator()(const f32x4 (&acc)[2][2][4][2], const Unit& u_, int wr, int wc, int fr, int fq) const {
        const int which = u_.pn >> 2; Unit u = u_; u.pn &= 3;
        if (which == 0) { float* QK = (float*)(ws + WS_SCR);
            EPI_LOOP_BEGIN
                f32x4* p = (f32x4*)(QK + (size_t)row * D + col); p[0] = v0; p[1] = v1;
            EPI_LOOP_END
        } else { bf16_t* base = (bf16_t*)(ws + WS_SCR + (size_t)(which + 1) * 32 * MiB);
            EPI_LOOP_BEGIN
                *(u32x4*)(base + (size_t)row * D + col) = pack8(v0, v1);
            EPI_LOOP_END
        }
    }
};

struct EpiRKV {
    static constexpr bool PERM = true, AFTER_DRAIN = false;
    unsigned char* ws;
    __device__ __forceinline__ void operator()(const f32x4 (&acc)[2][2][4][2], const Unit& u, int wr, int wc, int fr, int fq) const {
        bf16_t* base = (bf16_t*)(ws + WS_SCR + (size_t)(96 + 32 * u.gi) * MiB);
        EPI_LOOP_BEGIN
            *(u32x4*)(base + (size_t)row * D + col) = pack8(v0, v1);
        EPI_LOOP_END
    }
};
struct EpiL1 {
    static constexpr bool PERM = true, AFTER_DRAIN = false;
    unsigned char* ws;
    __device__ __forceinline__ void operator()(const f32x4 (&acc)[2][2][4][2], const Unit& u, int wr, int wc, int fr, int fq) const {
        bf16_t* base = (bf16_t*)(ws + WS_SCR + (size_t)192 * MiB);
        EPI_LOOP_BEGIN
            if (bj == 1) {
#pragma unroll
                for (int e = 0; e < 4; ++e) { v0[e] = sigmoidf_(v0[e]); v1[e] = sigmoidf_(v1[e]); }
            } else if (wc < 2) {
#pragma unroll
                for (int e = 0; e < 4; ++e) { v0[e] = 1.f - 2.f / (__expf(2.f * v0[e]) + 1.f); v1[e] = 1.f - 2.f / (__expf(2.f * v1[e]) + 1.f); }
            }
            *(u32x4*)(base + (size_t)row * 1024 + col) = pack8(v0, v1);
        EPI_LOOP_END
    }
};
struct EpiL2 {
    static constexpr bool PERM = true, AFTER_DRAIN = false;
    unsigned char* ws; const float* w0; const float* a0;
    __device__ __forceinline__ void operator()(const f32x4 (&acc)[2][2][4][2], const Unit& u_, int wr, int wc, int fr, int fq) const {
        const int which = u_.pn >> 2; Unit u = u_; u.pn &= 3;
        if (which == 0) { float* W = (float*)(ws + WS_SCR);
            EPI_LOOP_BEGIN
                const f32x4 b0 = *(const f32x4*)(w0 + col), b1 = *(const f32x4*)(w0 + col + 4);
#pragma unroll
                for (int e = 0; e < 4; ++e) { float z = -(b0[e] + v0[e]); float sp = fmaxf(z, 0.f) + __logf(1.f + __expf(-fabsf(z))); v0[e] = __expf(-__expf(-sp - 0.5f));
                    z = -(b1[e] + v1[e]); sp = fmaxf(z, 0.f) + __logf(1.f + __expf(-fabsf(z))); v1[e] = __expf(-__expf(-sp - 0.5f)); }
                f32x4* p = (f32x4*)(W + (size_t)row * D + col); p[0] = v0; p[1] = v1;
            EPI_LOOP_END
        } else if (which == 1) { bf16_t* A = (bf16_t*)(ws + WS_SCR + (size_t)64 * MiB);
            EPI_LOOP_BEGIN
                const f32x4 b0 = *(const f32x4*)(a0 + col), b1 = *(const f32x4*)(a0 + col + 4);
#pragma unroll
                for (int e = 0; e < 4; ++e) { v0[e] = sigmoidf_(b0[e] + v0[e]); v1[e] = sigmoidf_(b1[e] + v1[e]); }
                *(u32x4*)(A + (size_t)row * D + col) = pack8(v0, v1);
            EPI_LOOP_END
        } else { bf16_t* G = (bf16_t*)(ws + WS_SCR + (size_t)224 * MiB);
            EPI_LOOP_BEGIN
                *(u32x4*)(G + (size_t)row * D + col) = pack8(v0, v1);
            EPI_LOOP_END
        }
    }
};
namespace da {
typedef float f32x16 __attribute__((ext_vector_type(16)));
typedef short s16x4 __attribute__((ext_vector_type(4)));
typedef short v4i16_t __attribute__((ext_vector_type(4)));
typedef __attribute__((address_space(3))) const char* lds_cptr;
constexpr int NSLOT = 3, SLOTB = 32768, VOFF = 16384;
constexpr int L_WSF = NSLOT * SLOTB, L_TB = L_WSF + 8 * 256, L_END = L_TB + 512;
constexpr int L_XCH = 0, L_OST = 65536;
static_assert(L_END <= RING_BYTES && L_OST + 4 * 8192 <= NSLOT * SLOTB, "attention LDS map");
__device__ const unsigned char BUCKET[128] = {0,1,2,3,4,5,6,7,8,9,10,11,12,13,14,15,16,16,16,17,17,18,18,18,19,19,19,20,20,20,20,21,21,21,21,22,22,22,22,22,23,23,23,23,23,23,24,24,24,24,24,24,25,25,25,25,25,25,25,26,26,26,26,26,26,26,26,27,27,27,27,27,27,27,27,27,27,28,28,28,28,28,28,28,28,28,28,29,29,29,29,29,29,29,29,29,29,29,29,30,30,30,30,30,30,30,30,30,30,30,30,30,30,31,31,31,31,31,31,31,31,31,31,31,31,31,31,31};
constexpr float LOG2E = 1.4426950408889634f;
constexpr float QSCALE = 0.125f * LOG2E;

__device__ __forceinline__ int crow(int r, int hi) { return (r & 3) + 8 * (r >> 2) + 4 * hi; }
__device__ __forceinline__ void glds16(const void* gsrc, unsigned lds_dst) { unsigned keep;
    asm volatile("s_mov_b32 %0, m0\n\ts_mov_b32 m0, %2\n\ts_nop 0\n\tglobal_load_lds_dwordx4 %1, off\n\ts_mov_b32 m0, %0" : "=&s"(keep) : "v"(gsrc), "s"(lds_dst) : "memory"); }
__device__ __forceinline__ s16x4 vtr(lds_cptr p) { return __builtin_bit_cast(s16x4, __builtin_amdgcn_ds_read_tr16_b64_v4i16((__attribute__((address_space(3))) v4i16_t*)p)); }
typedef float f32x2_t __attribute__((ext_vector_type(2))); typedef __bf16 bf16x2_t __attribute__((ext_vector_type(2)));
__device__ __forceinline__ unsigned cvtpk(float lo, float hi) { f32x2_t v = {lo, hi}; bf16x2_t b = __builtin_convertvector(v, bf16x2_t); return __builtin_bit_cast(unsigned, b); }
#define DA_WAIT_BAR(N) asm volatile("s_waitcnt vmcnt(" #N ") lgkmcnt(0)\n\ts_barrier" ::: "memory")

__device__ __forceinline__ void attn_unit(int b, int h, int qb, const bf16* Q, const bf16* __restrict__ K, const bf16* __restrict__ V, bf16* O, LAS unsigned char* lds,
                                          const float* lq1, const float* lk1, const float* lq2, const float* lk2, const float* subg, const float* rel_bias, float lam_init) {
    int tid_ = threadIdx.x; asm volatile("" : "+v"(tid_));
    const int tid = tid_, lane = tid & 63, r32 = lane & 31, hi = lane >> 5; const int wid = __builtin_amdgcn_readfirstlane(tid >> 6);
    const int qg = wid & 3, mp = wid >> 2;
    const long rowbase = (long)b * SEQ; const int q0 = qb * 128, qa = q0 + 32 * qg;
    const unsigned lds0 = (unsigned)(size_t)lds;
    const lds_cptr L = (lds_cptr)lds;
    LAS float* wsf = (LAS float*)(lds + L_WSF) + wid * 64;
    LAS float* tb = (LAS float*)(lds + L_TB);
    const int NT = (q0 + 128) / 64;
    DA_WAIT_BAR(0);
    const bf16* Kh = K + rowbase * D + h * 128; const bf16* Vh = V + rowbase * D + h * 128;
    const bf16* ks0; const bf16* ks1; const bf16* vs0; const bf16* vs1; unsigned kd0, kd1, vd0, vd1;
    { const int p0_ = 2 * wid, p1_ = 2 * wid + 1;
      ks0 = Kh + (long)lane * D + (p0_ >> 3) * 64 + (p0_ & 7) * 8; ks1 = Kh + (long)lane * D + (p1_ >> 3) * 64 + (p1_ & 7) * 8; kd0 = lds0 + p0_ * 1024; kd1 = lds0 + p1_ * 1024;
      vs0 = Vh + (long)(16 * (p0_ & 3) + (lane >> 2)) * D + (p0_ >> 2) * 32 + (lane & 3) * 8; vs1 = Vh + (long)(16 * (p1_ & 3) + (lane >> 2)) * D + (p1_ >> 2) * 32 + (lane & 3) * 8;
      vd0 = lds0 + VOFF + p0_ * 1024; vd1 = lds0 + VOFF + p1_ * 1024; }
#define DA_DMA(t, slot) do { const long go_ = (long)(t) * 64 * D; const unsigned so_ = (unsigned)(slot) * SLOTB; \
        glds16(ks0 + go_, (unsigned)__builtin_amdgcn_readfirstlane(kd0 + so_)); glds16(ks1 + go_, (unsigned)__builtin_amdgcn_readfirstlane(kd1 + so_)); \
        glds16(vs0 + go_, (unsigned)__builtin_amdgcn_readfirstlane(vd0 + so_)); glds16(vs1 + go_, (unsigned)__builtin_amdgcn_readfirstlane(vd1 + so_)); } while (0)
    DA_DMA(0, 0); DA_DMA(1, 1);
    if (tid < 128) { const float far = rel_bias[31 * 8 + h]; tb[tid] = (rel_bias[(int)BUCKET[tid] * 8 + h] - far) * LOG2E; }
    const float lam = __expf(wave_sum(lq1[lane] * lk1[lane])) - __expf(wave_sum(lq2[lane] * lk2[lane])) + lam_init;
    const bf16* Qw = Q + (rowbase + qa) * D + h * 128 + mp * 64;
    pg8::bf16x8 qr[4];
#pragma unroll
    for (int d0 = 0; d0 < 4; ++d0) qr[d0] = *reinterpret_cast<const pg8::bf16x8*>(&Qw[(long)r32 * D + d0 * 16 + hi * 8]);
    float mrun = -1e30f, lrun = 0.f;
    f32x16 o[4];
#pragma unroll
    for (int i = 0; i < 4; ++i) o[i] = f32x16{};
    const int vlane = ((lane >> 4) & 1) * 32 + (lane & 3) * 8 + (4 * hi + ((lane & 15) >> 2)) * 64;
    int slot = 0;
    for (int t = 0; t < NT; ++t) {
        if (t + 1 < NT) { DA_WAIT_BAR(4); } else { DA_WAIT_BAR(0); }
        if (t + 2 < NT) { const int s2 = slot == 0 ? 2 : slot - 1; DA_DMA(t + 2, s2); }
        const int k0 = t * 64;
        if (k0 <= qa + 31) {
            const lds_cptr Ks = L + slot * SLOTB + mp * 8192 + hi * 1024 + r32 * 16;
            const lds_cptr Vs = L + slot * SLOTB + VOFF + vlane;
            f32x16 p0 = f32x16{}, p1 = f32x16{};
#pragma unroll
            for (int d0 = 0; d0 < 4; ++d0) {
                const pg8::bf16x8 b0 = *(const __attribute__((address_space(3))) pg8::bf16x8*)(Ks + d0 * 2048);
                const pg8::bf16x8 b1 = *(const __attribute__((address_space(3))) pg8::bf16x8*)(Ks + d0 * 2048 + 512);
                p0 = __builtin_amdgcn_mfma_f32_32x32x16_bf16(b0, qr[d0], p0, 0, 0, 0);
                p1 = __builtin_amdgcn_mfma_f32_32x32x16_bf16(b1, qr[d0], p1, 0, 0, 0);
            }
            if (k0 + 176 > qa) {
                const int qq = qa + r32;
#pragma unroll
                for (int r = 0; r < 16; ++r) {
                    const int rel0 = qq - (k0 + crow(r, hi)), rel1 = rel0 - 32;
                    const float b0 = tb[rel0 < 0 ? 0 : (rel0 > 127 ? 127 : rel0)], b1 = tb[rel1 < 0 ? 0 : (rel1 > 127 ? 127 : rel1)];
                    p0[r] = rel0 < 0 ? -INFINITY : p0[r] + b0; p1[r] = rel1 < 0 ? -INFINITY : p1[r] + b1;
                }
            }
            float rm = fmaxf(p0[0], p1[0]);
#pragma unroll
            for (int r = 1; r < 16; ++r) rm = fmaxf(rm, fmaxf(p0[r], p1[r]));
            { auto rr = __builtin_amdgcn_permlane32_swap(__float_as_uint(rm), __float_as_uint(rm), false, false); rm = fmaxf(__uint_as_float(rr[0]), __uint_as_float(rr[1])); }
            const float mnew = fmaxf(mrun, rm);
            if (__any(mnew > mrun)) {
                const float al = __builtin_amdgcn_exp2f(mrun - mnew);
                lrun *= al; mrun = mnew;
                if (hi == 0) wsf[r32] = al;
                asm volatile("s_waitcnt lgkmcnt(0)" ::: "memory");
#pragma unroll
                for (int r = 0; r < 16; ++r) { const float f = wsf[crow(r, hi)];
#pragma unroll
                    for (int db = 0; db < 4; ++db) o[db][r] *= f; }
            }
            float sacc = 0.f;
#pragma unroll
            for (int r = 0; r < 16; ++r) { p0[r] = __builtin_amdgcn_exp2f(p0[r] - mrun); p1[r] = __builtin_amdgcn_exp2f(p1[r] - mrun); sacc += p0[r] + p1[r]; }
            lrun += sacc;
            pg8::u32x4 pw0, pw1, pw2, pw3;
            pw0 = (pg8::u32x4){cvtpk(p0[0], p0[1]), cvtpk(p0[2], p0[3]), cvtpk(p0[4], p0[5]), cvtpk(p0[6], p0[7])};
            pw1 = (pg8::u32x4){cvtpk(p0[8], p0[9]), cvtpk(p0[10], p0[11]), cvtpk(p0[12], p0[13]), cvtpk(p0[14], p0[15])};
            pw2 = (pg8::u32x4){cvtpk(p1[0], p1[1]), cvtpk(p1[2], p1[3]), cvtpk(p1[4], p1[5]), cvtpk(p1[6], p1[7])};
            pw3 = (pg8::u32x4){cvtpk(p1[8], p1[9]), cvtpk(p1[10], p1[11]), cvtpk(p1[12], p1[13]), cvtpk(p1[14], p1[15])};
#define DA_VF(db, ks) ({ const s16x4 lo_ = vtr(Vs + (db) * 4096 + (ks) * 1024), hi_ = vtr(Vs + (db) * 4096 + (ks) * 1024 + 512); (pg8::bf16x8){lo_[0], lo_[1], lo_[2], lo_[3], hi_[0], hi_[1], hi_[2], hi_[3]}; })
#pragma unroll
            for (int db = 0; db < 4; ++db) {
                o[db] = __builtin_amdgcn_mfma_f32_32x32x16_bf16(__builtin_bit_cast(pg8::bf16x8, pw0), DA_VF(db, 0), o[db], 0, 0, 0);
                o[db] = __builtin_amdgcn_mfma_f32_32x32x16_bf16(__builtin_bit_cast(pg8::bf16x8, pw1), DA_VF(db, 1), o[db], 0, 0, 0);
                o[db] = __builtin_amdgcn_mfma_f32_32x32x16_bf16(__builtin_bit_cast(pg8::bf16x8, pw2), DA_VF(db, 2), o[db], 0, 0, 0);
                o[db] = __builtin_amdgcn_mfma_f32_32x32x16_bf16(__builtin_bit_cast(pg8::bf16x8, pw3), DA_VF(db, 3), o[db], 0, 0, 0);
            }
        }
        slot = slot == 2 ? 0 : slot + 1;
    }
    { auto rr = __builtin_amdgcn_permlane32_swap(__float_as_uint(lrun), __float_as_uint(lrun), false, false); lrun = __uint_as_float(rr[0]) + __uint_as_float(rr[1]); }
    if (hi == 0) wsf[32 + r32] = 1.0f / lrun;
    DA_WAIT_BAR(0);
    float rli[16];
#pragma unroll
    for (int r = 0; r < 16; ++r) rli[r] = wsf[32 + crow(r, hi)];
    LAS float* xch = (LAS float*)(lds + L_XCH) + qg * 4096;
    if (mp == 1) {
#pragma unroll
        for (int r = 0; r < 16; ++r)
#pragma unroll
            for (int db = 0; db < 4; ++db) xch[crow(r, hi) * 128 + db * 32 + r32] = o[db][r] * rli[r];
    }
    DA_WAIT_BAR(0);
    if (mp == 0) {
        float ss[16];
#pragma unroll
        for (int r = 0; r < 16; ++r) { float s = 0.f;
#pragma unroll
            for (int db = 0; db < 4; ++db) { const float d = o[db][r] * rli[r] - lam * xch[crow(r, hi) * 128 + db * 32 + r32]; o[db][r] = d; s += d * d; }
            ss[r] = s; }
#pragma unroll
        for (int r = 0; r < 16; ++r) {
#pragma unroll
            for (int off = 1; off < 32; off <<= 1) ss[r] += __shfl_xor(ss[r], off);
            ss[r] = (1.f - lam_init) / sqrtf(ss[r] * (1.f / 128.f) + 1e-5f); }
        LAS unsigned short* stg = (LAS unsigned short*)(lds + L_OST) + qg * 4096;
#pragma unroll
        for (int db = 0; db < 4; ++db) { const float g = subg[db * 32 + r32];
#pragma unroll
            for (int r = 0; r < 16; ++r) stg[crow(r, hi) * 128 + db * 32 + r32] = (unsigned short)f2bf(o[db][r] * ss[r] * g); }
        asm volatile("s_waitcnt lgkmcnt(0)" ::: "memory");
        bf16* Ow = O + (rowbase + qa) * D + h * 128;
#pragma unroll
        for (int i = 0; i < 8; ++i) { const int idx = i * 64 + lane, row = idx >> 4, ch = idx & 15;
            const pg8::u32x4 v = *(const LAS pg8::u32x4*)(stg + row * 128 + ch * 8); *(pg8::u32x4*)(Ow + (long)row * D + ch * 8) = v; }
    }
#undef DA_DMA
#undef DA_VF
}
__device__ __forceinline__ void attn_phase(Frame& F, int layer, int j, const float* rel_bias, const float* lq1, const float* lk1, const float* lq2, const float* lk2, const float* subg) {
    const float lam_init = 0.8f - 0.6f * __expf(-0.3f * (float)layer);
    const bf16* Qb = (const bf16*)(F.ws + WS_SCR); const bf16* Kb = (const bf16*)(F.ws + WS_SCR + 32 * MiB); const bf16* Vb = (const bf16*)(F.ws + WS_SCR + 64 * MiB);
    if (F.G != 256) return;
    const int xcd = F.vcu >> 5, c = F.vcu & 31;
    for (int i = 0; i < 4; ++i) {
        const int bh = xcd * 4 + i, qb = (i & 1) ? 31 - c : c;
        attn_unit(bh >> 3, bh & 7, qb, Qb, Kb, Vb, (bf16*)Qb, F.lds + RING_OFF, lq1 + j * 64, lk1 + j * 64, lq2 + j * 64, lk2 + j * 64, subg + j * 128, rel_bias, lam_init);
    }
    DA_WAIT_BAR(0);
}
}
namespace gla {
using da::f32x16; using da::s16x4; using da::lds_cptr; using da::vtr; using da::glds16; using da::crow; using da::cvtpk;
constexpr size_t O_QK = WS_SCR, O_V = WS_SCR + 64 * MiB, O_R = WS_SCR + 96 * MiB, O_QD = WS_SCR + 128 * MiB, O_KD = WS_SCR + 144 * MiB, O_KD2 = WS_SCR + 160 * MiB,
                 O_DEC = WS_SCR + 176 * MiB, O_KV = WS_SCR, O_S = WS_SCR + 178 * MiB;
constexpr int NCH = 64, CH = 64, GH = 4, DK = 128, DV = 256;
#define GL_WAIT_BAR(N) asm volatile("s_waitcnt vmcnt(" #N ") lgkmcnt(0)\n\ts_barrier" ::: "memory")
__device__ __forceinline__ float bf2f(unsigned short v) { return __uint_as_float((unsigned)v << 16); }

__device__ __forceinline__ void prep_phase(Frame& F, const float* w_a1, const float* w_a2, const float* b_a) {
    LAS float* a1s = (LAS float*)(F.lds + RING_OFF);
    const int tid = F.tid;
    const float* QK = (const float*)(F.ws + O_QK);
    bf16* QD = (bf16*)(F.ws + O_QD); bf16* KD = (bf16*)(F.ws + O_KD); bf16* KD2 = (bf16*)(F.ws + O_KD2); float* DEC = (float*)(F.ws + O_DEC);
    for (int u = F.vcu; u < BATCH * NCH; u += F.G) {
        const int m0 = u * CH;
        __syncthreads();
        { const int tk = tid >> 3, jj = tid & 7; const float* hr = F.H + (size_t)(m0 + tk) * D; float s0 = 0.f, s1 = 0.f;
#pragma unroll 4
          for (int k = 0; k < D; k += 4) { const f32x4 hv = *(const f32x4*)(hr + k);
#pragma unroll
              for (int e = 0; e < 4; ++e) { const float* w = w_a1 + (size_t)(k + e) * 16 + 2 * jj; s0 = fmaf(hv[e], w[0], s0); s1 = fmaf(hv[e], w[1], s1); } }
          a1s[tk * 16 + 2 * jj] = s0; a1s[tk * 16 + 2 * jj + 1] = s1; }
        __syncthreads();
        const int c = tid;
        float w2[16];
#pragma unroll
        for (int i = 0; i < 16; ++i) w2[i] = w_a2[i * 512 + c];
        const float ba = b_a[c];
        float bl = 0.f;
        for (int t = 0; t < CH; ++t) { float x = ba;
#pragma unroll
            for (int i = 0; i < 16; ++i) x = fmaf(a1s[t * 16 + i], w2[i], x);
            bl += (fminf(x, 0.f) - __logf(1.f + __expf(-fabsf(x)))) * (1.f / 16.f); }
        DEC[(size_t)u * 512 + c] = __expf(bl);
        float bc = 0.f;
        for (int t = 0; t < CH; ++t) { float x = ba;
#pragma unroll
            for (int i = 0; i < 16; ++i) x = fmaf(a1s[t * 16 + i], w2[i], x);
            bc += (fminf(x, 0.f) - __logf(1.f + __expf(-fabsf(x)))) * (1.f / 16.f);
            const size_t r = (size_t)(m0 + t);
            const float q = QK[r * D + c], k = QK[r * D + 512 + c];
            QD[r * 512 + c] = (bf16)f2bf(q * 0.08838834764831845f * __expf(bc));
            KD[r * 512 + c] = (bf16)f2bf(k * __expf(-bc));
            KD2[r * 512 + c] = (bf16)f2bf(k * __expf(bl - bc)); }
    }
}

__device__ __forceinline__ void kv_phase(Frame& F) {
    int tid_ = threadIdx.x; asm volatile("" : "+v"(tid_));
    const int tid = tid_, lane = tid & 63, r32 = lane & 31, hi = lane >> 5; const int wid = __builtin_amdgcn_readfirstlane(tid >> 6);
    const unsigned lds0 = (unsigned)(size_t)(F.lds + RING_OFF); const lds_cptr L = (lds_cptr)(F.lds + RING_OFF);
    const bf16* KD2 = (const bf16*)(F.ws + O_KD2); const bf16* V = (const bf16*)(F.ws + O_V); bf16* KV = (bf16*)(F.ws + O_KV);
    const int vlane = ((lane >> 4) & 1) * 32 + (lane & 3) * 8 + (4 * hi + ((lane & 15) >> 2)) * 64;
    for (int u = F.vcu; u < BATCH * GH * NCH; u += F.G) {
        const int c = u & 63, h = (u >> 6) & 3, b = u >> 8; const size_t m0 = (size_t)b * SEQ + c * CH;
        GL_WAIT_BAR(0);
        {
            const bf16* ksrc = KD2 + (m0 + (lane >> 2)) * 512 + h * 128 + (lane & 3) * 8; const bf16* vsrc = V + (m0 + (lane >> 2)) * D + h * 256 + wid * 32 + (lane & 3) * 8;
#pragma unroll
            for (int i = 0; i < 2; ++i) { const int pi = 2 * wid + i; glds16(ksrc + (size_t)(16 * (pi & 3)) * 512 + (pi >> 2) * 32, (unsigned)__builtin_amdgcn_readfirstlane(lds0 + pi * 1024)); }
#pragma unroll
            for (int i = 0; i < 4; ++i) glds16(vsrc + (size_t)(16 * i) * D, (unsigned)__builtin_amdgcn_readfirstlane(lds0 + 16384 + (4 * wid + i) * 1024));
        }
        GL_WAIT_BAR(0);
        f32x16 acc[4];
#pragma unroll
        for (int dt = 0; dt < 4; ++dt) acc[dt] = f32x16{};
#pragma unroll
        for (int ks = 0; ks < 4; ++ks) {
            const s16x4 bl_ = vtr(L + 16384 + wid * 4096 + ks * 1024 + vlane), bh_ = vtr(L + 16384 + wid * 4096 + ks * 1024 + 512 + vlane);
            const pg8::bf16x8 bfr = (pg8::bf16x8){bl_[0], bl_[1], bl_[2], bl_[3], bh_[0], bh_[1], bh_[2], bh_[3]};
#pragma unroll
            for (int dt = 0; dt < 4; ++dt) {
                const s16x4 al_ = vtr(L + dt * 4096 + ks * 1024 + vlane), ah_ = vtr(L + dt * 4096 + ks * 1024 + 512 + vlane);
                const pg8::bf16x8 afr = (pg8::bf16x8){al_[0], al_[1], al_[2], al_[3], ah_[0], ah_[1], ah_[2], ah_[3]};
                acc[dt] = __builtin_amdgcn_mfma_f32_32x32x16_bf16(afr, bfr, acc[dt], 0, 0, 0);
            }
        }
        bf16* kvu = KV + (size_t)u * 32768 + (size_t)(wid * 32 + r32) * 128;
#pragma unroll
        for (int dt = 0; dt < 4; ++dt)
#pragma unroll
            for (int g = 0; g < 4; ++g) { u32x2 w; w.x = cvtpk(acc[dt][4 * g], acc[dt][4 * g + 1]); w.y = cvtpk(acc[dt][4 * g + 2], acc[dt][4 * g + 3]);
                *(u32x2*)(kvu + dt * 32 + 8 * g + 4 * hi) = w; }
    }
    GL_WAIT_BAR(0);
}

__device__ __forceinline__ void scan_phase(Frame& F) {
    const bf16* KV = (const bf16*)(F.ws + O_KV); bf16* S = (bf16*)(F.ws + O_S); const float* DEC = (const float*)(F.ws + O_DEC);
    for (int gid = F.vcu * 512 + F.tid; gid < BATCH * GH * 8192; gid += F.G * 512) {
        const int bh = gid >> 13, rem = gid & 8191, e = rem >> 5, d4 = (rem & 31) * 4, b = bh >> 2, h = bh & 3;
        float s0 = 0.f, s1 = 0.f, s2 = 0.f, s3 = 0.f;
        const size_t base = (size_t)bh * NCH * 32768 + (size_t)e * 128 + d4;
#pragma unroll 8
        for (int c = 0; c < NCH; ++c) {
            const u32x2 kv = *(const u32x2*)(KV + base + (size_t)c * 32768);
            const f32x4 dc = *(const f32x4*)(DEC + ((size_t)(b * NCH + c)) * 512 + h * 128 + d4);
            u32x2 w; w.x = cvtpk(s0, s1); w.y = cvtpk(s2, s3);
            *(u32x2*)(S + base + (size_t)c * 32768) = w;
            s0 = fmaf(s0, dc[0], __uint_as_float(kv.x << 16)); s1 = fmaf(s1, dc[1], __uint_as_float(kv.x & 0xffff0000u));
            s2 = fmaf(s2, dc[2], __uint_as_float(kv.y << 16)); s3 = fmaf(s3, dc[3], __uint_as_float(kv.y & 0xffff0000u));
        }
    }
}

__device__ __forceinline__ void out_phase(Frame& F, const float* norm_g) {
    int tid_ = threadIdx.x; asm volatile("" : "+v"(tid_));
    const int tid = tid_, lane = tid & 63, r32 = lane & 31, hi = lane >> 5; const int wid = __builtin_amdgcn_readfirstlane(tid >> 6);
    const unsigned lds0 = (unsigned)(size_t)(F.lds + RING_OFF); const lds_cptr L = (lds_cptr)(F.lds + RING_OFF);
    const bf16* QD = (const bf16*)(F.ws + O_QD); const bf16* KD = (const bf16*)(F.ws + O_KD); const bf16* V = (const bf16*)(F.ws + O_V); const bf16* S = (const bf16*)(F.ws + O_S);
    const bf16* Rr = (const bf16*)(F.ws + O_R); bf16* YN = (bf16*)(F.ws + O_V);
    const int vlane = ((lane >> 4) & 1) * 32 + (lane & 3) * 8 + (4 * hi + ((lane & 15) >> 2)) * 64;
    constexpr int OSTR = 264;
    LAS float* ol = (LAS float*)(F.lds + RING_OFF);
    LAS float* rs = (LAS float*)(F.lds + RING_OFF + 64 * OSTR * 4);
    for (int u = F.vcu; u < BATCH * GH * NCH; u += F.G) {
        const int c = u & 63, h = (u >> 6) & 3, b = u >> 8; const size_t m0 = (size_t)b * SEQ + c * CH;
        GL_WAIT_BAR(0);
        {
            const bf16* qsrc = QD + (m0 + lane) * 512 + h * 128 + 2 * wid * 8; const bf16* ksrc = KD + (m0 + lane) * 512 + h * 128 + 2 * wid * 8;
            const bf16* vsrc = V + (m0 + (lane >> 2)) * D + h * 256 + wid * 32 + (lane & 3) * 8; const bf16* ssrc = S + (size_t)u * 32768 + (size_t)lane * 128 + 2 * wid * 8;
#pragma unroll
            for (int i = 0; i < 2; ++i) { glds16(qsrc + i * 8, (unsigned)__builtin_amdgcn_readfirstlane(lds0 + (2 * wid + i) * 1024)); glds16(ksrc + i * 8, (unsigned)__builtin_amdgcn_readfirstlane(lds0 + 16384 + (2 * wid + i) * 1024)); }
#pragma unroll
            for (int i = 0; i < 4; ++i) glds16(vsrc + (size_t)(16 * i) * D, (unsigned)__builtin_amdgcn_readfirstlane(lds0 + 32768 + (4 * wid + i) * 1024));
#pragma unroll
            for (int i = 0; i < 8; ++i) glds16(ssrc + (size_t)((i & 3) * 64) * 128 + (i >> 2) * 8, (unsigned)__builtin_amdgcn_readfirstlane(lds0 + 65536 + ((2 * wid + (i >> 2)) * 4 + (i & 3)) * 1024));
        }
        GL_WAIT_BAR(0);
        f32x16 o[2]; o[0] = f32x16{}; o[1] = f32x16{};
#pragma unroll
        for (int tix = 0; tix < 3; ++tix) {
            const int jt = tix == 2 ? 1 : 0, it = tix == 0 ? 0 : 1;
            f32x16 x = f32x16{};
#pragma unroll
            for (int s = 0; s < 8; ++s) {
                const pg8::bf16x8 kf = *(const __attribute__((address_space(3))) pg8::bf16x8*)(L + 16384 + (2 * s + hi) * 1024 + (jt * 32 + r32) * 16);
                const pg8::bf16x8 qf = *(const __attribute__((address_space(3))) pg8::bf16x8*)(L + (2 * s + hi) * 1024 + (it * 32 + r32) * 16);
                x = __builtin_amdgcn_mfma_f32_32x32x16_bf16(kf, qf, x, 0, 0, 0);
            }
            if (jt == it) {
#pragma unroll
                for (int r = 0; r < 16; ++r) if (crow(r, hi) > r32) x[r] = 0.f;
            }
            const pg8::u32x4 pw0 = (pg8::u32x4){cvtpk(x[0], x[1]), cvtpk(x[2], x[3]), cvtpk(x[4], x[5]), cvtpk(x[6], x[7])};
            const pg8::u32x4 pw1 = (pg8::u32x4){cvtpk(x[8], x[9]), cvtpk(x[10], x[11]), cvtpk(x[12], x[13]), cvtpk(x[14], x[15])};
#pragma unroll
            for (int ks = 0; ks < 2; ++ks) {
                const int kv = 2 * jt + ks;
                const s16x4 lo_ = vtr(L + 32768 + wid * 4096 + kv * 1024 + vlane), hi_ = vtr(L + 32768 + wid * 4096 + kv * 1024 + 512 + vlane);
                const pg8::bf16x8 vf = (pg8::bf16x8){lo_[0], lo_[1], lo_[2], lo_[3], hi_[0], hi_[1], hi_[2], hi_[3]};
                o[it] = __builtin_amdgcn_mfma_f32_32x32x16_bf16(__builtin_bit_cast(pg8::bf16x8, ks == 0 ? pw0 : pw1), vf, o[it], 0, 0, 0);
            }
        }
#pragma unroll
        for (int s = 0; s < 8; ++s) {
            const pg8::bf16x8 sf = *(const __attribute__((address_space(3))) pg8::bf16x8*)(L + 65536 + (2 * s + hi) * 4096 + (wid * 32 + r32) * 16);
#pragma unroll
            for (int it = 0; it < 2; ++it) {
                const pg8::bf16x8 qf = *(const __attribute__((address_space(3))) pg8::bf16x8*)(L + (2 * s + hi) * 1024 + (it * 32 + r32) * 16);
                o[it] = __builtin_amdgcn_mfma_f32_32x32x16_bf16(qf, sf, o[it], 0, 0, 0);
            }
        }
        GL_WAIT_BAR(0);
#pragma unroll
        for (int it = 0; it < 2; ++it)
#pragma unroll
            for (int r = 0; r < 16; ++r) ol[(it * 32 + crow(r, hi)) * OSTR + wid * 32 + r32] = o[it][r];
        GL_WAIT_BAR(0);
        { const int i = tid >> 3, seg = tid & 7; float ss = 0.f;
#pragma unroll
          for (int k = 0; k < 32; ++k) { const float v = ol[i * OSTR + k * 8 + seg]; ss = fmaf(v, v, ss); }
          ss += __shfl_xor(ss, 1); ss += __shfl_xor(ss, 2); ss += __shfl_xor(ss, 4);
          if (seg == 0) rs[i] = 1.0f / sqrtf(ss * (1.f / 256.f) + 1e-5f); }
        GL_WAIT_BAR(0);
        { const float g = norm_g[wid * 32 + r32];
#pragma unroll
          for (int it = 0; it < 2; ++it)
#pragma unroll
            for (int r = 0; r < 16; ++r) { const int i = it * 32 + crow(r, hi); const size_t gi = (m0 + i) * D + h * 256 + wid * 32 + r32;
                const float rv = bf2f(Rr[gi]); const float y = o[it][r] * rs[i] * g * (rv / (1.f + __expf(-rv)));
                YN[gi] = (bf16)f2bf(y); } }
    }
    GL_WAIT_BAR(0);
}
}
namespace rw {
constexpr size_t O_XM = WS_SCR, O_W = WS_SCR, O_A = WS_SCR + 64 * MiB, O_RKV = WS_SCR + 96 * MiB, O_L1 = WS_SCR + 192 * MiB, O_Y = WS_SCR + 192 * MiB, O_G = WS_SCR + 224 * MiB;
constexpr int NH = 16, HN = 64;
#define RW_WAIT_BAR() asm volatile("s_waitcnt vmcnt(0) lgkmcnt(0)\n\ts_barrier" ::: "memory")
__device__ __forceinline__ float bf2f(unsigned short v) { return __uint_as_float((unsigned)v << 16); }
__device__ __forceinline__ f32x4 bf4(u32x2 w) { f32x4 r; r[0] = __uint_as_float(w.x << 16); r[1] = __uint_as_float(w.x & 0xffff0000u); r[2] = __uint_as_float(w.y << 16); r[3] = __uint_as_float(w.y & 0xffff0000u); return r; }

__device__ __forceinline__ void mix_phase(Frame& F, const float* mix) {
    const int gw = F.vcu * NWAVES + F.wave, NGW = F.G * NWAVES;
    for (int m = gw; m < M; m += NGW) {
        const GAS f32x4* xr = (const GAS f32x4*)(F.H + (size_t)m * D) + F.lane; const bool first = (m & (SEQ - 1)) == 0;
#pragma unroll
        for (int j = 0; j < 4; ++j) {
            const f32x4 x = xr[64 * j]; const f32x4 xp = first ? (f32x4){0.f, 0.f, 0.f, 0.f} : *((const GAS f32x4*)(F.H + (size_t)(m - 1) * D) + F.lane + 64 * j);
            const f32x4 dx = xp - x;
#pragma unroll
            for (int g = 0; g < 3; ++g) { const f32x4 mg = *((const GAS f32x4*)(mix + g * D) + F.lane + 64 * j); const f32x4 o = x + dx * mg;
                u32x2 w; w.x = pk2(o.x, o.y); w.y = pk2(o.z, o.w);
                *((GAS u32x2*)((bf16*)(F.ws + O_XM) + (size_t)g * M * D + (size_t)m * D) + F.lane + 64 * j) = w; }
        }
    }
}

constexpr int TCH = 16, NCHK = SEQ / TCH, SLOT_F = TCH * 6 * 64;
constexpr int L_RING = 0, L_Y = 3 * SLOT_F * 4;
template <int CTRL> __device__ __forceinline__ float dppmov(float v) { return __builtin_bit_cast(float, __builtin_amdgcn_update_dpp(0, __builtin_bit_cast(int, v), CTRL, 0xF, 0xF, false)); }
__device__ __forceinline__ float dpp_sum16(float v) {
    v += dppmov<0xB1>(v); v += dppmov<0x4E>(v); v += dppmov<0x124>(v); v += dppmov<0x128>(v); return v; }
__device__ __forceinline__ void scan_phase(Frame& F, const float* k_k, const float* k_a) {
    int tid_ = threadIdx.x; asm volatile("" : "+v"(tid_));
    const int tid = tid_, lane = tid & 63; const int wid = __builtin_amdgcn_readfirstlane(tid >> 6);
    LAS float* ring = (LAS float*)(F.lds + RING_OFF + L_RING); LAS float* ybuf = (LAS float*)(F.lds + RING_OFF + L_Y);
    const bf16* RKV = (const bf16*)(F.ws + O_RKV); const float* Wd = (const float*)(F.ws + O_W); const bf16* Aa = (const bf16*)(F.ws + O_A); bf16* Y = (bf16*)(F.ws + O_Y);
    for (int u = F.vcu; u < BATCH * NH * 4; u += F.G) {
        const int qt = u & 3, h = (u >> 2) & 15, b = u >> 6; const size_t row0 = (size_t)b * SEQ;
        RW_WAIT_BAR();
        if (wid >= 4) {
            const int lt = tid - 256, tk = lt >> 4, c4 = (lt & 15) * 4, ch = h * HN + c4;
            const f32x4 kkv = *(const f32x4*)(k_k + ch), kav = *(const f32x4*)(k_a + ch);
            u32x2 r_n, k_n, v_n, a_n; f32x4 w_n;
#define RW_LOAD(c) do { const size_t gi_ = (row0 + (size_t)(c) * TCH + tk) * D + ch; r_n = *(const u32x2*)(RKV + gi_); k_n = *(const u32x2*)(RKV + (size_t)M * D + gi_); v_n = *(const u32x2*)(RKV + 2 * (size_t)M * D + gi_); \
        a_n = *(const u32x2*)(Aa + gi_); w_n = *(const f32x4*)(Wd + gi_); } while (0)
#define RW_PUT(slot) do { LAS float* s_ = ring + (slot) * SLOT_F + tk * 384 + c4; const f32x4 r_ = bf4(r_n), k_ = bf4(k_n), v_ = bf4(v_n), a_ = bf4(a_n); \
        f32x4 kk_ = k_ * kkv; float ss_ = (kk_[0] * kk_[0] + kk_[1] * kk_[1]) + (kk_[2] * kk_[2] + kk_[3] * kk_[3]); ss_ = dpp_sum16(ss_); \
        kk_ = kk_ * (1.0f / sqrtf(fmaxf(ss_, 1e-24f))); const f32x4 kp_ = k_ * ((a_ - 1.f) * kav + 1.f); \
        *(LAS f32x4*)(s_) = w_n; *(LAS f32x4*)(s_ + 64) = kk_ * a_; *(LAS f32x4*)(s_ + 128) = kp_; *(LAS f32x4*)(s_ + 192) = kk_; *(LAS f32x4*)(s_ + 256) = r_; *(LAS f32x4*)(s_ + 320) = v_; } while (0)
            RW_LOAD(0); RW_PUT(0); RW_LOAD(1); RW_PUT(1); RW_LOAD(2);
            RW_WAIT_BAR();
            int slot = 2;
            for (int c = 0; c < NCHK; ++c) {
                if (c + 2 < NCHK) { RW_PUT(slot); }
                if (c + 3 < NCHK) { RW_LOAD(c + 3); }
                if (c > 0) { const LAS float* yb = ybuf + ((c - 1) & 1) * 256;
                    const int t = lt >> 4, rr = lt & 15;
                    Y[(row0 + (size_t)(c - 1) * TCH + t) * D + h * HN + qt * 16 + rr] = (bf16)f2bf(yb[t * 16 + rr]); }
                slot = slot == 2 ? 0 : slot + 1;
                RW_WAIT_BAR();
            }
            { const LAS float* yb = ybuf + ((NCHK - 1) & 1) * 256; const int t = lt >> 4, rr = lt & 15;
              Y[(row0 + (size_t)(NCHK - 1) * TCH + t) * D + h * HN + qt * 16 + rr] = (bf16)f2bf(yb[t * 16 + rr]); }
#undef RW_LOAD
#undef RW_PUT
        } else {
            const int rl = wid * 4 + (lane >> 4), ks = (lane & 15) * 4, vrow = qt * 16 + rl;
            f32x4 S = (f32x4){0.f, 0.f, 0.f, 0.f};
            RW_WAIT_BAR();
            int slot = 0;
            for (int c = 0; c < NCHK; ++c) {
                const LAS float* sb = ring + slot * SLOT_F; LAS float* yb = ybuf + (c & 1) * 256;
#pragma unroll 4
                for (int t = 0; t < TCH; ++t) {
                    const LAS float* s_ = sb + t * 384;
                    const f32x4 w = *(const LAS f32x4*)(s_ + ks), bb = *(const LAS f32x4*)(s_ + 64 + ks), kp = *(const LAS f32x4*)(s_ + 128 + ks), kk = *(const LAS f32x4*)(s_ + 192 + ks), r = *(const LAS f32x4*)(s_ + 256 + ks);
                    const float v = s_[320 + vrow];
                    float sa = (S[0] * kk[0] + S[1] * kk[1]) + (S[2] * kk[2] + S[3] * kk[3]);
                    sa = -dpp_sum16(sa);
                    S = S * w + (bb * sa + kp * v);
                    float y = (S[0] * r[0] + S[1] * r[1]) + (S[2] * r[2] + S[3] * r[3]);
                    y = dpp_sum16(y);
                    if ((lane & 15) == 0) yb[t * 16 + rl] = y;
                }
                slot = slot == 2 ? 0 : slot + 1;
                RW_WAIT_BAR();
            }
        }
    }
    RW_WAIT_BAR();
}

__device__ __forceinline__ void post_phase(Frame& F, const float* k_a, const float* r_k, const float* ln_g, const float* ln_b) {
    const bf16* RKV = (const bf16*)(F.ws + O_RKV); const bf16* Aa = (const bf16*)(F.ws + O_A); const bf16* G = (const bf16*)(F.ws + O_G); bf16* Y = (bf16*)(F.ws + O_Y);
    const int c4 = (F.tid & 15) * 4;
    for (size_t gidx = (size_t)F.vcu * 32 + (F.tid >> 4); gidx < (size_t)M * NH; gidx += (size_t)F.G * 32) {
        const size_t m = gidx >> 4; const int h = (int)(gidx & 15), ch = h * HN + c4; const size_t gi = m * D + ch;
        const f32x4 y = bf4(*(const u32x2*)(Y + gi)), r = bf4(*(const u32x2*)(RKV + gi)), k = bf4(*(const u32x2*)(RKV + (size_t)M * D + gi)), v = bf4(*(const u32x2*)(RKV + 2 * (size_t)M * D + gi));
        const f32x4 a = bf4(*(const u32x2*)(Aa + gi)), g = bf4(*(const u32x2*)(G + gi));
        const f32x4 kav = *(const f32x4*)(k_a + ch), rkv = *(const f32x4*)(r_k + ch), lg = *(const f32x4*)(ln_g + ch), lb = *(const f32x4*)(ln_b + ch);
        const float mean = dpp_sum16((y[0] + y[1]) + (y[2] + y[3])) * (1.f / 64.f);
        const f32x4 dy = y - mean;
        const float var = dpp_sum16((dy[0] * dy[0] + dy[1] * dy[1]) + (dy[2] * dy[2] + dy[3] * dy[3])) * (1.f / 64.f);
        const f32x4 kp = k * ((a - 1.f) * kav + 1.f);
        const f32x4 rk = r * kp * rkv;
        const float bonus = dpp_sum16((rk[0] + rk[1]) + (rk[2] + rk[3]));
        const f32x4 o = (dy * (1.0f / sqrtf(var + 64e-5f)) * lg + lb + v * bonus) * g;
        u32x2 w; w.x = pk2(o[0], o[1]); w.y = pk2(o[2], o[3]);
        *(u32x2*)(Y + gi) = w;
    }
}
}
enum StepKind { K_INIT = 0, K_CONV = 1, K_LN1 = 2, K_UP = 3, K_DOWN = 4, K_LN2 = 5, K_GATE = 6, K_QKV = 7, K_ATTN = 8, K_WO = 9, K_GIN = 10, K_GPREP = 11, K_GKV = 12, K_GSCAN = 13, K_GOUT = 14, K_RMIX = 15, K_NKINDS };
constexpr int MAX_STEPS = 96;
struct Args { const float* in[40]; float* out; unsigned char* ws; int lo, hi, bar_region, pad; };
static_assert(sizeof(Args) % 8 == 0, "Args: no tail padding");

struct CfgUp   { static constexpr int np = 2; static constexpr PD p0 = mkpd(FF, D, -1, 2048, WS_WUP, 2048), p1 = mkpd(D, PLE, WS_PB, 2048, WS_WPROJ, 2048), p2 = p1; };
struct CfgDown { static constexpr int np = 1; static constexpr PD p0 = mkpd(D, FF, WS_HID, 8192, WS_WDOWN, 8192), p1 = p0, p2 = p0; };
struct CfgQKV  { static constexpr int np = 1; static constexpr PD p0 = mkpd(3 * D, D, -1, 2048, WS_WMIX, 2048), p1 = p0, p2 = p0; };
struct CfgWoA  { static constexpr int np = 1; static constexpr PD p0 = mkpd(D, D, WS_SCR, 2048, WS_WMIX + 6 * MiB, 2048), p1 = p0, p2 = p0; };
struct CfgWoB  { static constexpr int np = 1; static constexpr PD p0 = mkpd(D, D, WS_SCR + 64 * MiB, 2048, WS_WMIX + 6 * MiB, 2048), p1 = p0, p2 = p0; };
struct CfgWoC  { static constexpr int np = 1; static constexpr PD p0 = mkpd(D, D, WS_SCR + 192 * MiB, 2048, WS_WMIX + 7 * MiB, 2048), p1 = p0, p2 = p0; };
struct CfgRKV  { static constexpr int np = 3; static constexpr PD p0 = mkpd(D, D, WS_SCR, 2048, WS_WMIX, 2048), p1 = mkpd(D, D, WS_SCR + 32 * MiB, 2048, WS_WMIX + 2 * MiB, 2048), p2 = mkpd(D, D, WS_SCR + 64 * MiB, 2048, WS_WMIX + 4 * MiB, 2048); };
struct CfgRL1  { static constexpr int np = 1; static constexpr PD p0 = mkpd(256, 2 * D, -2, 2048, WS_WMIX + 6 * MiB, 4096), p1 = p0, p2 = p0; };
struct CfgRL2  { static constexpr int np = 1; static constexpr PD p0 = mkpd(3 * D, 256, WS_SCR + 192 * MiB, 2048, WS_WMIX + 9 * MiB, 2048), p1 = p0, p2 = p0; };
struct CfgGate { static constexpr int np = 1; static constexpr PD p0 = mkpd(D, D, -1, 2048, WS_WGATE, 2048), p1 = p0, p2 = p0; };
__device__ __forceinline__ const float* inp(int i) { return ((const float* const __attribute__((address_space(4)))*)__builtin_amdgcn_kernarg_segment_ptr())[i]; }

#define MK_STEP(s, ...) do { if (lo <= (s) && (s) < hi) { if ((s) > lo) xcd_barrier(bar); \
        { int t_ = threadIdx.x; asm volatile("" : "+v"(t_)); F.tid = t_; F.lane = t_ & 63; F.wave = __builtin_amdgcn_readfirstlane(t_ >> 6); } __VA_ARGS__ } } while (0)
#define MK_GEMM(CFG, EPI, LDA, LDB, ...) do { SchedC<CFG> S{ws, F.G, bx_}; EPI E{__VA_ARGS__}; pg8::gemm_phase<EPI, SchedC<CFG>, true, true>(F.lds + RING_OFF, LDA, LDB, S, E); } while (0)

template <int L> __device__ __forceinline__ void mk_layer(Frame& F, const XcdBarrier& bar, const int lo, const int hi, const int bx_) {
    unsigned char* const ws = F.ws;
    constexpr int KIND = L % 3, J = L / 3, S0 = 1 + 16 * L;
    MK_STEP(S0,
        if (F.tid == 0) { int n = 0;
            put_job(F, n, inp(7) + (size_t)L * D * FF, D, FF, (bf16*)(ws + WS_WUP), 0, D, 0);
            put_job(F, n, inp(8) + (size_t)L * FF * D, FF, D, (bf16*)(ws + WS_WDOWN), 0, FF, 0);
            put_job(F, n, inp(10) + (size_t)L * D * D, D, D, (bf16*)(ws + WS_WGATE), 0, D, 0);
            put_job(F, n, inp(9) + (size_t)L * PLE * D, PLE, D, (bf16*)(ws + WS_WPROJ), 0, D, 0);
            if (KIND == 0) {
                put_job(F, n, inp(11) + (size_t)J * D * 3 * D, D, 3 * D, (bf16*)(ws + WS_WMIX), 0, D, 0);
                put_job(F, n, inp(12) + (size_t)J * D * D, D, D, (bf16*)(ws + WS_WMIX + 6 * MiB), 0, D, 0); }
            if (KIND == 1) {
                put_job(F, n, inp(18) + (size_t)J * D * 3 * D, D, 3 * D, (bf16*)(ws + WS_WMIX), 0, D, 0);
                put_job(F, n, inp(23) + (size_t)J * D * D, D, D, (bf16*)(ws + WS_WMIX + 6 * MiB), 0, D, 0); }
            if (KIND == 2) { const float* mix = inp(24) + (size_t)J * 6 * D;
                for (int g = 0; g < 3; ++g) put_job(F, n, inp(25) + ((size_t)J * 3 + g) * D * D, D, D, (bf16*)(ws + WS_WMIX + (size_t)g * 2 * MiB), 0, D, 0);
                bf16* wc = (bf16*)(ws + WS_WMIX + 6 * MiB);
                put_job(F, n, inp(27) + (size_t)J * D * 64, D, 64, wc, 0, 2 * D, 0, mix + 3 * D, 0);    put_job(F, n, inp(27) + (size_t)J * D * 64, D, 64, wc, 0, 2 * D, D, mix + 3 * D, 1);
                put_job(F, n, inp(30) + (size_t)J * D * 64, D, 64, wc, 64, 2 * D, 0, mix + 4 * D, 0);   put_job(F, n, inp(30) + (size_t)J * D * 64, D, 64, wc, 64, 2 * D, D, mix + 4 * D, 1);
                put_job(F, n, inp(32) + (size_t)J * D * 128, D, 128, wc, 128, 2 * D, 0, mix + 5 * D, 0); put_job(F, n, inp(32) + (size_t)J * D * 128, D, 128, wc, 128, 2 * D, D, mix + 5 * D, 1);
                bf16* w2c = (bf16*)(ws + WS_WMIX + 9 * MiB);
                put_job(F, n, inp(28) + (size_t)J * 64 * D, 64, D, w2c, 0, 1024, 0);        put_job(F, n, nullptr, 192, D, w2c, 0, 1024, 64);
                put_job(F, n, nullptr, 64, D, w2c, D, 1024, 0);                             put_job(F, n, inp(31) + (size_t)J * 64 * D, 64, D, w2c, D, 1024, 64);      put_job(F, n, nullptr, 128, D, w2c, D, 1024, 128);
                put_job(F, n, nullptr, 128, D, w2c, 2 * D, 1024, 0);                        put_job(F, n, inp(33) + (size_t)J * 128 * D, 128, D, w2c, 2 * D, 1024, 128);
                put_job(F, n, inp(39) + (size_t)J * D * D, D, D, (bf16*)(ws + WS_WMIX + 7 * MiB), 0, D, 0); }
            F.MISC[16] = n; }
        __syncthreads();
        conv_run(F, (int)F.MISC[16]);
        __syncthreads(); );
    if constexpr (KIND == 0) {
        MK_STEP(S0 + 1, MK_GEMM(CfgQKV, EpiQKV, 2048u, 2048u, ws, da::QSCALE); );
        MK_STEP(S0 + 2, da::attn_phase(F, L, J, inp(2), inp(13), inp(14), inp(15), inp(16), inp(17)); );
        MK_STEP(S0 + 7, MK_GEMM(CfgWoA, EpiResid, 2048u, 2048u, F.H); );
    } else if constexpr (KIND == 1) {
        MK_STEP(S0 + 1, MK_GEMM(CfgQKV, EpiGIN, 2048u, 2048u, ws); );
        MK_STEP(S0 + 2, gla::prep_phase(F, inp(19) + (size_t)J * D * 16, inp(20) + (size_t)J * 16 * 512, inp(21) + J * 512); );
        MK_STEP(S0 + 3, gla::kv_phase(F); );
        MK_STEP(S0 + 4, gla::scan_phase(F); );
        MK_STEP(S0 + 5, gla::out_phase(F, inp(22) + J * 256); );
        MK_STEP(S0 + 7, MK_GEMM(CfgWoB, EpiResid, 2048u, 2048u, F.H); );
    } else {
        MK_STEP(S0 + 1, rw::mix_phase(F, inp(24) + (size_t)J * 6 * D); );
        MK_STEP(S0 + 2, MK_GEMM(CfgRL1, EpiL1, 2048u, 4096u, ws); );
        MK_STEP(S0 + 3, MK_GEMM(CfgRKV, EpiRKV, 2048u, 2048u, ws); );
        MK_STEP(S0 + 4, MK_GEMM(CfgRL2, EpiL2, 2048u, 2048u, ws, inp(26) + J * D, inp(29) + J * D); );
        MK_STEP(S0 + 5, rw::scan_phase(F, inp(34) + J * D, inp(35) + J * D); );
        MK_STEP(S0 + 6, rw::post_phase(F, inp(35) + J * D, inp(36) + J * D, inp(37) + J * D, inp(38) + J * D); );
        MK_STEP(S0 + 7, MK_GEMM(CfgWoC, EpiResid, 2048u, 2048u, F.H); );
    }
    MK_STEP(S0 + 8, ln_phase(F, inp(3) + L * D, inp(4) + L * D); pb_phase(F, inp(1) + (size_t)L * M * PLE); );
    MK_STEP(S0 + 9, MK_GEMM(CfgUp, EpiUpPP, 2048u, 2048u, ws); );
    MK_STEP(S0 + 10, MK_GEMM(CfgDown, EpiResid, 8192u, 8192u, F.H); );
    MK_STEP(S0 + 11, ln_phase(F, inp(5) + L * D, inp(6) + L * D); );
    MK_STEP(S0 + 12, MK_GEMM(CfgGate, EpiGate, 2048u, 2048u, F.H, ws); );
}

__global__ void __launch_bounds__(NWAVES * 64, 2) mk_fwd(Args args) {
    extern __shared__ __attribute__((aligned(16))) unsigned char lds[];
    Frame F;
    F.lds = (LAS unsigned char*)lds;
    F.MISC = (volatile LAS unsigned*)(F.lds + MISC_OFF);
    F.tid = threadIdx.x; F.lane = F.tid & 63; F.wave = __builtin_amdgcn_readfirstlane(F.tid >> 6);
    const int bx_ = blockIdx.x;
    F.G = gridDim.x; F.vcu = (F.G % 8 == 0) ? (bx_ % 8) * (F.G / 8) + bx_ / 8 : bx_;
    F.ws = args.ws; F.H = args.out;
    F.ctl = (gu32*)(F.ws + WS_CTL);
    for (int u = F.tid; u < (LDS_BYTES - LDSCTL_OFF) / 4; u += NWAVES * 64) ((LAS unsigned*)(F.lds + LDSCTL_OFF))[u] = 0u;
    __syncthreads();
    const XcdBarrier bar = xcd_barrier_post((unsigned*)(F.ctl + CW_BAR) + args.bar_region * XCD_BAR_WORDS, F.MISC + 8);
    const int lo = args.lo, hi = args.hi;
    MK_STEP(0, init_phase(F, inp(0)); );
    mk_layer<0>(F, bar, lo, hi, bx_);
    mk_layer<1>(F, bar, lo, hi, bx_);
    mk_layer<2>(F, bar, lo, hi, bx_);
    mk_layer<3>(F, bar, lo, hi, bx_);
}

static int mk_grid = 0;
static bool mk_setup() {
    if (mk_grid == 0) {
        int dev = 0, cus = 0, per_cu = 0;
        if (hipGetDevice(&dev) != hipSuccess || hipDeviceGetAttribute(&cus, hipDeviceAttributeMultiprocessorCount, dev) != hipSuccess) { mk_grid = -1; return false; }
        if (hipFuncSetAttribute((const void*)mk_fwd, hipFuncAttributeMaxDynamicSharedMemorySize, LDS_BYTES) != hipSuccess) { fprintf(stderr, "mk: hipFuncSetAttribute failed\n"); mk_grid = -1; return false; }
        if (hipOccupancyMaxActiveBlocksPerMultiprocessor(&per_cu, (const void*)mk_fwd, NWAVES * 64, LDS_BYTES) != hipSuccess || per_cu < 1) { fprintf(stderr, "mk: occupancy query says %d blocks per CU\n", per_cu); (void)hipGetLastError(); mk_grid = -1; return false; }
        mk_grid = cus;
    }
    return mk_grid > 0;
}
static void mk_launch(void* const* d_in, float* out, unsigned char* ws, int lo, int hi, int bar_region, hipStream_t stream) {
    Args a{};
    for (int i = 0; i < 40; ++i) a.in[i] = (const float*)d_in[i];
    a.out = out; a.ws = ws; a.lo = lo; a.hi = hi; a.bar_region = bar_region; a.pad = 0;
    hipLaunchKernelGGL(mk_fwd, dim3(mk_grid), dim3(NWAVES * 64), LDS_BYTES, stream, a);
}
#ifndef MK_PER_LAYER
#define MK_PER_LAYER 0
#endif
extern "C" void kernel_launch(void* const* d_in, const int* in_sizes, int n_in, void* d_out, int out_size, void* d_ws, size_t ws_size, hipStream_t stream) {
    if (!mk_setup()) return;
    if (ws_size < WS_END_MIN) { fprintf(stderr, "ws too small: %zu\n", ws_size); return; }
    unsigned char* ws = (unsigned char*)d_ws; float* H = (float*)d_out;
    hipMemsetAsync(ws + WS_CTL, 0, CTL_ZERO_BYTES, stream);
#if MK_PER_LAYER
    mk_launch(d_in, H, ws, 0, 17, 0, stream);
    for (int i = 1; i < DEPTH; ++i) mk_launch(d_in, H, ws, 1 + 16 * i, 17 + 16 * i, i, stream);
#else
    mk_launch(d_in, H, ws, 0, 1 + 16 * DEPTH, 0, stream);
#endif
}
```
